# Optimizing an MI355X kernel written in HIP

```python
import math
import jax
import jax.numpy as jnp
from jax import lax
import numpy as np

D_MODEL = 1024
BATCH = 8
SEQ = 2048
DEPTH = 4
DEC_BATCH = 128
DEC_SEQ = 8
PAST_LEN = 16384
PAGE_SIZE = 128

N_MIXERS = 3
CONV_W = 4
EPS = 1e-6
H_A = 8
DK_A = 128
DV_A = 128
D_QK_A = H_A * DK_A
D_V_A = H_A * DV_A
D_CONV_A = 2 * D_QK_A + D_V_A
D_IN_A = D_CONV_A + D_V_A + 2 * H_A
CHUNK_A = 64
CHUNK_B = 128
D_B = 2 * D_MODEL
H_B = 8
DG_B = D_B // H_B
D_IN_B = 2 * D_B
D_INNER_C = 2 * D_MODEL
P_C = 64
H_C = D_INNER_C // P_C
G_C = 4
R_C = H_C // G_C
N_C = 128
D_XBC_C = D_INNER_C + 2 * G_C * N_C
D_IN_C = D_INNER_C + D_XBC_C + H_C
CHUNK_C = 128
D_FF = 2816
N_LAYERS_A = (DEPTH + 2) // 3
N_LAYERS_B = (DEPTH + 1) // 3
N_LAYERS_C = DEPTH // 3

kernel_name = "hybrid_gdn_chunkmlp_ssd_decoder_step"


def rms_norm(x, w):
    xf = x.astype(jnp.float32)
    y = xf * lax.rsqrt(jnp.mean(xf * xf, axis=-1, keepdims=True) + EPS)
    return (y * w.astype(jnp.float32)).astype(x.dtype)


def layer_norm(x, w, b):
    xf = x.astype(jnp.float32)
    mu = jnp.mean(xf, axis=-1, keepdims=True)
    var = jnp.mean(jnp.square(xf - mu), axis=-1, keepdims=True)
    return ((xf - mu) * lax.rsqrt(var + EPS) * w.astype(jnp.float32) + b.astype(jnp.float32)).astype(x.dtype)


def l2norm(x):
    xf = x.astype(jnp.float32)
    return xf * lax.rsqrt(jnp.sum(xf * xf, axis=-1, keepdims=True) + EPS)


def swiglu(x, w_in, w_out):
    g, u = jnp.split(x @ w_in, 2, axis=-1)
    return (jax.nn.silu(g) * u) @ w_out


def half_ffn(x, w_pre, w_post, w_in, w_out):
    return x + 0.5 * rms_norm(swiglu(rms_norm(x, w_pre), w_in, w_out), w_post)


def causal_dwconv(x, buf, w):
    L = x.shape[1]
    xp = jnp.concatenate([buf.astype(x.dtype), x], axis=1)
    y = sum(xp[:, j:j + L] * w[j] for j in range(CONV_W))
    return y, xp[:, L:]


def to_chunks(a, c):
    B, L = a.shape[:2]
    n = -(-L // c)
    a = jnp.pad(a, [(0, 0), (0, n * c - L)] + [(0, 0)] * (a.ndim - 2))
    return a.reshape((B, n, c) + a.shape[2:])


def gated_delta_chunked(q, k, v, g, beta, s0):
    B, L = q.shape[:2]
    c = min(CHUNK_A, L)
    f32 = jnp.float32
    q, k, v = [to_chunks(a.astype(f32), c).swapaxes(2, 3) for a in (q, k, v)]
    g, beta = [to_chunks(a.astype(f32), c).swapaxes(2, 3) for a in (g, beta)]
    G = jnp.cumsum(g, axis=-1)
    causal = jnp.tril(jnp.ones((c, c), bool))
    strict = jnp.tril(jnp.ones((c, c), bool), -1)
    gamma = jnp.exp(jnp.where(causal, G[..., :, None] - G[..., None, :], -jnp.inf))
    kb = k * beta[..., None]
    m = jnp.where(strict, jnp.einsum('bzhid,bzhjd->bzhij', kb, k) * gamma, 0.0)
    rhs = jnp.concatenate([v * beta[..., None], kb * jnp.exp(G)[..., None]], axis=-1)
    sol = lax.linalg.triangular_solve(jnp.eye(c, dtype=f32) + m, rhs, left_side=True, lower=True,
                                      unit_diagonal=True)
    u_ps, w_ps = sol[..., :DV_A], sol[..., DV_A:]
    attn = jnp.einsum('bzhid,bzhjd->bzhij', q, k) * gamma
    q_dec = q * jnp.exp(G)[..., None]
    k_dec = k * jnp.exp(G[..., -1:] - G)[..., None]
    g_tot = jnp.exp(G[..., -1])

    def step(S, inp):
        u_c, w_c, a_c, qd_c, kd_c, gt_c = inp
        v_new = u_c - jnp.einsum('bhid,bhde->bhie', w_c, S)
        o = jnp.einsum('bhid,bhde->bhie', qd_c, S) + jnp.einsum('bhij,bhje->bhie', a_c, v_new)
        S = S * gt_c[..., None, None] + jnp.einsum('bhjd,bhje->bhde', kd_c, v_new)
        return S, o

    xs = tuple(jnp.moveaxis(a, 1, 0) for a in (u_ps, w_ps, attn, q_dec, k_dec, g_tot))
    s_fin, o = lax.scan(step, s0.astype(f32), xs)
    o = jnp.moveaxis(o, 0, 1).swapaxes(2, 3)
    o = o.reshape(B, -1, H_A, DV_A)[:, :L]
    return o, s_fin


def ssd_chunked(x, dt, a, bm, cm, s0):
    B, L = x.shape[:2]
    c = min(CHUNK_C, L)
    f32 = jnp.float32
    x = to_chunks(x.astype(f32), c).reshape(B, -1, c, G_C, R_C, P_C)
    dt = to_chunks(dt.astype(f32), c).reshape(B, -1, c, G_C, R_C)
    bm = to_chunks(bm.astype(f32), c)
    cm = to_chunks(cm.astype(f32), c)
    G = jnp.cumsum(dt * a.astype(f32).reshape(G_C, R_C), axis=2)
    causal = jnp.tril(jnp.ones((c, c), bool))[:, :, None, None]
    seg = jnp.exp(jnp.where(causal, G[:, :, :, None] - G[:, :, None, :], -jnp.inf))
    xdt = x * dt[..., None]
    cb = jnp.einsum('bzigs,bzjgs->bzgij', cm, bm)
    y_diag = jnp.einsum('bzgij,bzijgr,bzjgrp->bzigrp', cb, seg, xdt)
    dec_end = jnp.exp(G[:, :, -1:] - G)
    states = jnp.einsum('bzjgs,bzjgr,bzjgrp->bzgrps', bm, dec_end, xdt)
    chunk_dec = jnp.exp(G[:, :, -1])

    def step(S, inp):
        st, gd = inp
        return S * gd[..., None, None] + st, S

    s_init = s0.astype(f32).reshape(B, G_C, R_C, P_C, N_C)
    s_fin, s_prev = lax.scan(step, s_init, (jnp.moveaxis(states, 1, 0), jnp.moveaxis(chunk_dec, 1, 0)))
    s_prev = jnp.moveaxis(s_prev, 0, 1)
    y_off = jnp.einsum('bzigs,bzigr,bzgrps->bzigrp', cm, jnp.exp(G), s_prev)
    y = (y_diag + y_off).reshape(B, -1, H_C, P_C)[:, :L]
    return y, s_fin.reshape(B, H_C, P_C, N_C)


def gdn_mixer(h, conv_buf, s0, w_in, conv_w, a_log, dt_bias, norm_w, w_out):
    B, L, _ = h.shape
    qkv, gate, a_in, b_in = jnp.split(h @ w_in, [D_CONV_A, D_CONV_A + D_V_A, D_CONV_A + D_V_A + H_A], axis=-1)
    qkv, new_buf = causal_dwconv(qkv, conv_buf, conv_w)
    qkv = jax.nn.silu(qkv)
    q, k, v = jnp.split(qkv, [D_QK_A, 2 * D_QK_A], axis=-1)
    q = l2norm(q.reshape(B, L, H_A, DK_A)) * (DK_A ** -0.5)
    k = l2norm(k.reshape(B, L, H_A, DK_A))
    v = v.reshape(B, L, H_A, DV_A)
    g = -jnp.exp(a_log.astype(jnp.float32)) * jax.nn.softplus(a_in.astype(jnp.float32) + dt_bias.astype(jnp.float32))
    beta = jax.nn.sigmoid(b_in.astype(jnp.float32))
    o, s_new = gated_delta_chunked(q, k, v, g, beta, s0)
    o = rms_norm(o.astype(h.dtype), norm_w) * jax.nn.silu(gate.reshape(B, L, H_A, DV_A))
    return o.reshape(B, L, D_V_A) @ w_out, (new_buf, s_new.astype(s0.dtype))


def chunk_mlp_mixer(h, w_in, b_in, ln_w, ln_b, w_s, b_s, w_out):
    B, L, _ = h.shape
    u, v = jnp.split(jax.nn.gelu(h @ w_in + b_in, approximate=False), 2, axis=-1)
    v = layer_norm(v, ln_w, ln_b)
    vc = to_chunks(v, CHUNK_B).reshape(B, -1, CHUNK_B, H_B, DG_B)
    ws = jnp.where(jnp.tril(jnp.ones((CHUNK_B, CHUNK_B), bool)), w_s, 0.0)
    mixed = jnp.einsum('hts,bzshd->bzthd', ws, vc) + b_s.T[None, None, :, :, None]
    mixed = mixed.reshape(B, -1, D_B)[:, :L]
    return (u * mixed) @ w_out, (v,)


def ssd_mixer(h, conv_buf, s0, w_in, conv_w, conv_b, dt_bias, a_log, d_skip, norm_w, w_out):
    B, L, _ = h.shape
    z, xbc, dt = jnp.split(h @ w_in, [D_INNER_C, D_INNER_C + D_XBC_C], axis=-1)
    xbc, new_buf = causal_dwconv(xbc, conv_buf, conv_w)
    xbc = jax.nn.silu(xbc + conv_b)
    x, bm, cm = jnp.split(xbc, [D_INNER_C, D_INNER_C + G_C * N_C], axis=-1)
    x = x.reshape(B, L, H_C, P_C)
    bm = bm.reshape(B, L, G_C, N_C)
    cm = cm.reshape(B, L, G_C, N_C)
    dt = jax.nn.softplus(dt.astype(jnp.float32) + dt_bias.astype(jnp.float32))
    a = -jnp.exp(a_log.astype(jnp.float32))
    y, s_new = ssd_chunked(x, dt, a, bm, cm, s0)
    y = y + x.astype(jnp.float32) * d_skip.astype(jnp.float32)[:, None]
    yg = (y.reshape(B, L, D_INNER_C).astype(h.dtype) * jax.nn.silu(z)).reshape(B, L, G_C, D_INNER_C // G_C)
    y = rms_norm(yg, norm_w.reshape(G_C, -1)).reshape(B, L, D_INNER_C)
    return y @ w_out, (new_buf, s_new.astype(s0.dtype))


def layer(i, x, conv_buf, rec_state, W):
    kind, j = i % N_MIXERS, i // N_MIXERS
    nw = W['norm_w'][i]
    x = half_ffn(x, nw[0], nw[1], W['ffn_w_in'][i, 0], W['ffn_w_out'][i, 0])
    h = rms_norm(x, nw[2])
    if kind == 0:
        m, new_state = gdn_mixer(h, conv_buf, rec_state, W['gdn_w_in'][j], W['gdn_conv_w'][j], W['gdn_a_log'][j],
                                 W['gdn_dt_bias'][j], W['gdn_norm_w'][j], W['gdn_w_out'][j])
    elif kind == 1:
        m, new_state = chunk_mlp_mixer(h, W['cmlp_w_in'][j], W['cmlp_b_in'][j], W['cmlp_ln_w'][j], W['cmlp_ln_b'][j],
                                       W['cmlp_w_s'][j], W['cmlp_b_s'][j], W['cmlp_w_out'][j])
    else:
        m, new_state = ssd_mixer(h, conv_buf, rec_state, W['ssd_w_in'][j], W['ssd_conv_w'][j], W['ssd_conv_b'][j],
                                 W['ssd_dt_bias'][j], W['ssd_a_log'][j], W['ssd_d'][j], W['ssd_norm_w'][j],
                                 W['ssd_w_out'][j])
    x = x + rms_norm(m, nw[3])
    x = half_ffn(x, nw[4], nw[5], W['ffn_w_in'][i, 1], W['ffn_w_out'][i, 1])
    return x, new_state


def _dt_bias(k, shape):
    dt = jnp.exp(jax.random.uniform(k, shape, minval=math.log(1e-3), maxval=math.log(1e-1)))
    return dt + jnp.log(-jnp.expm1(-dt))


def setup_inputs(seed: int = 0) -> dict:
    key = jax.random.key(seed)
    ks = iter(jax.random.split(key, 40))
    nrm = lambda shape, s: jax.random.normal(next(ks), shape, jnp.float32) * s
    gain = lambda shape: 1.0 + nrm(shape, 0.05)
    a_log = lambda shape: jnp.log(jax.random.uniform(next(ks), shape, minval=1.0, maxval=16.0))
    return {
        'x_prompt': nrm((BATCH, SEQ, D_MODEL), 1.0),
        'x_sample': nrm((DEC_BATCH, DEC_SEQ, D_MODEL), 1.0),
        'state_gdn': nrm((N_LAYERS_A, DEC_BATCH, H_A, DK_A, DV_A), 0.5),
        'state_gdn_conv': nrm((N_LAYERS_A, DEC_BATCH, CONV_W - 1, D_CONV_A), 1.0),
        'state_ssd': nrm((N_LAYERS_C, DEC_BATCH, H_C, P_C, N_C), 0.1),
        'state_ssd_conv': nrm((N_LAYERS_C, DEC_BATCH, CONV_W - 1, D_XBC_C), 1.0),
        'norm_w': gain((DEPTH, 6, D_MODEL)),
        'ffn_w_in': nrm((DEPTH, 2, D_MODEL, 2 * D_FF), D_MODEL ** -0.5),
        'ffn_w_out': nrm((DEPTH, 2, D_FF, D_MODEL), D_FF ** -0.5),
        'gdn_w_in': nrm((N_LAYERS_A, D_MODEL, D_IN_A), D_MODEL ** -0.5),
        'gdn_conv_w': nrm((N_LAYERS_A, CONV_W, D_CONV_A), CONV_W ** -0.5),
        'gdn_a_log': a_log((N_LAYERS_A, H_A)),
        'gdn_dt_bias': _dt_bias(next(ks), (N_LAYERS_A, H_A)),
        'gdn_norm_w': gain((N_LAYERS_A, DV_A)),
        'gdn_w_out': nrm((N_LAYERS_A, D_V_A, D_MODEL), D_V_A ** -0.5),
        'cmlp_w_in': nrm((N_LAYERS_B, D_MODEL, D_IN_B), D_MODEL ** -0.5),
        'cmlp_b_in': nrm((N_LAYERS_B, D_IN_B), 0.02),
        'cmlp_ln_w': gain((N_LAYERS_B, D_B)),
        'cmlp_ln_b': nrm((N_LAYERS_B, D_B), 0.02),
        'cmlp_w_s': nrm((N_LAYERS_B, H_B, CHUNK_B, CHUNK_B), CHUNK_B ** -0.5),
        'cmlp_b_s': 1.0 + nrm((N_LAYERS_B, H_B, CHUNK_B), 0.1),
        'cmlp_w_out': nrm((N_LAYERS_B, D_B, D_MODEL), D_B ** -0.5),
        'ssd_w_in': nrm((N_LAYERS_C, D_MODEL, D_IN_C), D_MODEL ** -0.5),
        'ssd_conv_w': nrm((N_LAYERS_C, CONV_W, D_XBC_C), CONV_W ** -0.5),
        'ssd_conv_b': nrm((N_LAYERS_C, D_XBC_C), 0.02),
        'ssd_dt_bias': _dt_bias(next(ks), (N_LAYERS_C, H_C)),
        'ssd_a_log': a_log((N_LAYERS_C, H_C)),
        'ssd_d': gain((N_LAYERS_C, H_C)),
        'ssd_norm_w': gain((N_LAYERS_C, D_INNER_C)),
        'ssd_w_out': nrm((N_LAYERS_C, D_INNER_C, D_MODEL), D_INNER_C ** -0.5),
    }


def reference(x_prompt, x_sample, state_gdn, state_gdn_conv, state_ssd, state_ssd_conv,
              norm_w, ffn_w_in, ffn_w_out,
              gdn_w_in, gdn_conv_w, gdn_a_log, gdn_dt_bias, gdn_norm_w, gdn_w_out,
              cmlp_w_in, cmlp_b_in, cmlp_ln_w, cmlp_ln_b, cmlp_w_s, cmlp_b_s, cmlp_w_out,
              ssd_w_in, ssd_conv_w, ssd_conv_b, ssd_dt_bias, ssd_a_log, ssd_d, ssd_norm_w, ssd_w_out):
    W = dict(norm_w=norm_w, ffn_w_in=ffn_w_in, ffn_w_out=ffn_w_out,
             gdn_w_in=gdn_w_in, gdn_conv_w=gdn_conv_w, gdn_a_log=gdn_a_log, gdn_dt_bias=gdn_dt_bias,
             gdn_norm_w=gdn_norm_w, gdn_w_out=gdn_w_out,
             cmlp_w_in=cmlp_w_in, cmlp_b_in=cmlp_b_in, cmlp_ln_w=cmlp_ln_w, cmlp_ln_b=cmlp_ln_b,
             cmlp_w_s=cmlp_w_s, cmlp_b_s=cmlp_b_s, cmlp_w_out=cmlp_w_out,
             ssd_w_in=ssd_w_in, ssd_conv_w=ssd_conv_w, ssd_conv_b=ssd_conv_b, ssd_dt_bias=ssd_dt_bias,
             ssd_a_log=ssd_a_log, ssd_d=ssd_d, ssd_norm_w=ssd_norm_w, ssd_w_out=ssd_w_out)
    xp, xs = x_prompt, x_sample
    nb, dt_p = xp.shape[0], xp.dtype
    gdn_p, gdn_conv_p, ssd_p, ssd_conv_p = [], [], [], []
    gdn_s, gdn_conv_s, ssd_s, ssd_conv_s, cmlp_s = [], [], [], [], []
    for i in range(DEPTH):
        kind, j = i % N_MIXERS, i // N_MIXERS
        if kind == 0:
            bp = jnp.zeros((nb, CONV_W - 1, D_CONV_A), dt_p)
            sp = jnp.zeros((nb, H_A, DK_A, DV_A), dt_p)
            bs, ss = state_gdn_conv[j], state_gdn[j]
        elif kind == 2:
            bp = jnp.zeros((nb, CONV_W - 1, D_XBC_C), dt_p)
            sp = jnp.zeros((nb, H_C, P_C, N_C), dt_p)
            bs, ss = state_ssd_conv[j], state_ssd[j]
        else:
            bp = sp = bs = ss = None
        xp, new_p = layer(i, xp, bp, sp, W)
        xs, new_s = layer(i, xs, bs, ss, W)
        if kind == 0:
            gdn_conv_p.append(new_p[0]); gdn_p.append(new_p[1])
            gdn_conv_s.append(new_s[0]); gdn_s.append(new_s[1])
        elif kind == 1:
            cmlp_s.append(new_s[0])
        else:
            ssd_conv_p.append(new_p[0]); ssd_p.append(new_p[1])
            ssd_conv_s.append(new_s[0]); ssd_s.append(new_s[1])
    return (xp, xs,
            jnp.stack(gdn_p), jnp.stack(gdn_conv_p), jnp.stack(ssd_p), jnp.stack(ssd_conv_p),
            jnp.stack(gdn_s), jnp.stack(gdn_conv_s), jnp.stack(ssd_s), jnp.stack(ssd_conv_s),
            jnp.stack(cmlp_s))
```

```cpp
#include <hip/hip_runtime.h>
#include <hip/hip_cooperative_groups.h>
#include <cstdio>
namespace cg = cooperative_groups;

#ifndef MK_COOP
#define MK_COOP 1
#endif

#define MK_EMPTY 0
#ifndef MK_CGSYNC
#define MK_CGSYNC 0
#endif
#define MK_DBG 0
#define LAS __attribute__((address_space(3)))
typedef unsigned short bf16_t;
typedef short bf16x8 __attribute__((ext_vector_type(8)));
typedef float f32x4 __attribute__((ext_vector_type(4)));
typedef float f32x2 __attribute__((ext_vector_type(2)));
typedef unsigned u32x4 __attribute__((ext_vector_type(4)));
typedef unsigned u32x2 __attribute__((ext_vector_type(2)));

constexpr int TP = 16384, TS = 1024, T = TP + TS, D = 1024, DFF = 2816, SEQ = 2048;
constexpr int NGDN = 4352, NCM = 4096, NSSD = 5376;
constexpr float EPS = 1e-6f;
constexpr size_t O_X = 0;
constexpr size_t O_GDN_STATE_P = (size_t)T * D;
constexpr size_t O_GDN_CONV_P = O_GDN_STATE_P + (size_t)2 * 8 * 8 * 128 * 128;
constexpr size_t O_SSD_STATE_P = O_GDN_CONV_P + (size_t)2 * 8 * 3 * 3072;
constexpr size_t O_SSD_CONV_P = O_SSD_STATE_P + (size_t)8 * 32 * 64 * 128;
constexpr size_t O_GDN_STATE_S = O_SSD_CONV_P + (size_t)8 * 3 * 3072;
constexpr size_t O_GDN_CONV_S = O_GDN_STATE_S + (size_t)2 * 128 * 8 * 128 * 128;
constexpr size_t O_SSD_STATE_S = O_GDN_CONV_S + (size_t)2 * 128 * 3 * 3072;
constexpr size_t O_SSD_CONV_S = O_SSD_STATE_S + (size_t)128 * 32 * 64 * 128;
constexpr size_t O_CMLP_V_S = O_SSD_CONV_S + (size_t)128 * 3 * 3072;
constexpr size_t O_END = O_CMLP_V_S + (size_t)128 * 8 * 2048;
constexpr size_t WS_FFN_IN = 0;
constexpr size_t WS_FFN_OUT = WS_FFN_IN + (size_t)8 * 5632 * 1024 * 2;
constexpr size_t WS_GDN_IN = WS_FFN_OUT + (size_t)8 * 1024 * 2816 * 2;
constexpr size_t WS_GDN_OUT = WS_GDN_IN + (size_t)2 * NGDN * 1024 * 2;
constexpr size_t WS_CM_IN = WS_GDN_OUT + (size_t)2 * 1024 * 1024 * 2;
constexpr size_t WS_CM_OUT = WS_CM_IN + (size_t)NCM * 1024 * 2;
constexpr size_t WS_SSD_IN = WS_CM_OUT + (size_t)1024 * 2048 * 2;
constexpr size_t WS_SSD_OUT = WS_SSD_IN + (size_t)NSSD * 1024 * 2;
constexpr size_t WS_WSB = WS_SSD_OUT + (size_t)1024 * 2048 * 2;
constexpr size_t WS_H = WS_WSB + (size_t)8 * 128 * 128 * 2;
constexpr size_t WS_F = WS_H + (size_t)T * 1024 * 2;
constexpr size_t WS_P = WS_F + (size_t)T * 1024 * 4;
constexpr size_t WS_Q = WS_P + (size_t)T * NSSD * 2;
constexpr size_t WS_PART = WS_Q + (size_t)T * 2816 * 2;
constexpr size_t WS_AB = WS_Q + (size_t)T * 3072 * 4;
constexpr size_t WS_BAR = WS_AB + (size_t)T * 64 * 4;
constexpr size_t WS_G = WS_BAR + 16384;
constexpr size_t WS_END = WS_G + (size_t)64 * 2048 * 4;

constexpr int LDS_BYTES = 131072 + 16;

enum { OP_PROLOGUE = 0, OP_GEMM_SWIGLU, OP_GEMM_F32, OP_ROW, OP_GEMM_IN, OP_GEMM_IN_GELU, OP_GDN_PREP, OP_GDN_REC, OP_GDN_OUT,
       OP_CM_LN, OP_CM_MIX, OP_SSD_PREP, OP_SSD_REC, OP_SSD_OUT, OP_GDN_R1 };

struct Params {
    const float* in[30];
    float* out;
    unsigned char* ws;
    int lo, hi;
    unsigned char prog[64];
};
typedef const __attribute__((address_space(4))) Params* PP;

typedef __bf16 bf16v2 __attribute__((ext_vector_type(2)));
__device__ __forceinline__ unsigned cvt_pk_bf16(float lo, float hi) { f32x2 v = {lo, hi}; bf16v2 b = __builtin_convertvector(v, bf16v2); return __builtin_bit_cast(unsigned, b); }
__device__ __forceinline__ float bf_lo(unsigned w) { return __uint_as_float(w << 16); }
__device__ __forceinline__ float bf_hi(unsigned w) { return __uint_as_float(w & 0xffff0000u); }
__device__ __forceinline__ void unpack8(u32x4 w, float* f) { f[0] = bf_lo(w.x); f[1] = bf_hi(w.x); f[2] = bf_lo(w.y); f[3] = bf_hi(w.y); f[4] = bf_lo(w.z); f[5] = bf_hi(w.z); f[6] = bf_lo(w.w); f[7] = bf_hi(w.w); }
__device__ __forceinline__ float siluf(float x) { return x * __builtin_amdgcn_rcpf(1.0f + __expf(-x)); }
__device__ __forceinline__ float sigmoidf_(float x) { return __builtin_amdgcn_rcpf(1.0f + __expf(-x)); }
__device__ __forceinline__ float softplusf_(float x) { return x > 20.f ? x : log1pf(__expf(x)); }
template <int CTRL> __device__ __forceinline__ float dppf(float x) { return __int_as_float(__builtin_amdgcn_update_dpp(0, __float_as_int(x), CTRL, 0xF, 0xF, true)); }
__device__ __forceinline__ float red4(float x) { x += dppf<0xB1>(x); x += dppf<0x4E>(x); return x; }
__device__ __forceinline__ float red8(float x) { x = red4(x); x += dppf<0x141>(x); return x; }
__device__ __forceinline__ float red16(float x) { x = red8(x); x += dppf<0x140>(x); return x; }
__device__ __forceinline__ float red64(float x) { x = red16(x); x += __shfl_xor(x, 16); x += __shfl_xor(x, 32); return x; }

__device__ __forceinline__ void lds_barrier() { asm volatile("s_waitcnt lgkmcnt(0)" ::: "memory"); __builtin_amdgcn_s_barrier(); asm volatile("" ::: "memory"); }

namespace pg8 {
constexpr int BM = 256, BK = 64, HALF = 128, HTB = HALF * BK * 2, STAGE_BYTES = 8 * HTB, NXCD = 8, WGM = 4;
__device__ __forceinline__ int lds_byte(int r, int c) { const int st = (r >> 4) * 2 + (c >> 5), rr = r & 15, cc = c & 31, ob = rr * 64 + cc * 2; return st * 1024 + (ob ^ (((ob >> 9) & 1) << 5)); }
__device__ __forceinline__ void stage_rc(int b, int& R, int& C) { const int st = b / 1024, sb = b % 1024, swz = sb ^ (((sb >> 9) & 1) << 5); R = (st >> 1) * 16 + swz / 64; C = (st & 1) * 32 + (swz % 64) / 2; }
__device__ __forceinline__ int perm32(int rho) { const int n = rho >> 4, i = rho & 15; return 8 * (i >> 2) + 4 * n + (i & 3); }
struct Unit { int pm, pn, kz; };
struct Gemm { const bf16_t* A; const bf16_t* Bt; int M, N, K, lda, ldb; };
struct StaticOrder {
    int nM, nN, nwg, G, c;
    __device__ void init(int M, int N, int G_, int c_) { nM = M / BM; nN = N / BM; nwg = nM * nN; G = G_; c = c_; }
    __device__ bool next(int i, Unit& u) const {
        const long L = (long)i * G + c; if (L >= nwg) return false;
        int wgid = (int)L; { const int q = nwg / NXCD, r = nwg % NXCD, xcd = wgid % NXCD, off = wgid / NXCD; wgid = (xcd < r ? xcd * (q + 1) : r * (q + 1) + (xcd - r) * q) + off; }
        const int nig = WGM * nN, gid = wgid / nig, fm = gid * WGM, gsz = (nM - fm) < WGM ? (nM - fm) : WGM;
        u.pm = fm + ((wgid % nig) % gsz); u.pn = (wgid % nig) / gsz; u.kz = 0; return true;
    }
};
struct SplitOrder {
    int items, G, c;
    __device__ void init(int S, int G_, int c_) { items = 16 * S; G = G_; c = c_; }
    __device__ bool next(int i, Unit& u) const { const int L = i * G + c; if (L >= items) return false; u.kz = L >> 4; u.pm = (L >> 2) & 3; u.pn = L & 3; return true; }
};
struct EpiF32 {
    static constexpr bool PERM = false;
    float* C; int ldc;
    __device__ __forceinline__ void operator()(const f32x4 (&acc)[2][2][4][2], const Unit& u, int wr, int wc, int fr, int fq) const {
        const int row0 = u.pm * BM + wr * 64 + fr, col0 = u.pn * BM + wc * 32 + 4 * fq;
#pragma unroll
        for (int ai = 0; ai < 2; ++ai)
#pragma unroll
            for (int m = 0; m < 4; ++m) { float* rowp = C + (size_t)(row0 + ai * HALF + m * 16) * ldc + col0;
#pragma unroll
                for (int bj = 0; bj < 2; ++bj)
#pragma unroll
                    for (int n = 0; n < 2; ++n) *(f32x4*)(rowp + bj * HALF + n * 16) = acc[ai][bj][m][n]; }
    }
};
struct EpiBf16Part {
    static constexpr bool PERM = true;
    bf16_t* part;
    __device__ __forceinline__ void operator()(const f32x4 (&acc)[2][2][4][2], const Unit& u, int wr, int wc, int fr, int fq) const {
        const int row0 = u.pm * BM + wr * 64 + fr; const int col0 = u.pn * BM + wc * 32 + 8 * fq;
        bf16_t* C = part + (size_t)u.kz * 1024 * 1024;
#pragma unroll
        for (int ai = 0; ai < 2; ++ai)
#pragma unroll
            for (int m = 0; m < 4; ++m) { bf16_t* rowp = C + (size_t)(row0 + ai * HALF + m * 16) * 1024 + col0;
#pragma unroll
                for (int bj = 0; bj < 2; ++bj) { const f32x4 v0 = acc[ai][bj][m][0], v1 = acc[ai][bj][m][1];
                    u32x4 w; w.x = cvt_pk_bf16(v0[0], v0[1]); w.y = cvt_pk_bf16(v0[2], v0[3]); w.z = cvt_pk_bf16(v1[0], v1[1]); w.w = cvt_pk_bf16(v1[2], v1[3]);
                    *(u32x4*)(rowp + bj * HALF) = w; } }
    }
};
__device__ __forceinline__ f32x2 gelu_pk(f32x2 v) {
    const f32x2 av = __builtin_elementwise_abs(v), d = av * 0.2316418882f + 1.0f;
    f32x2 t; t.x = __builtin_amdgcn_rcpf(d.x); t.y = __builtin_amdgcn_rcpf(d.y);
    f32x2 q = t * 0.5307027145f + (-0.7265760135f); q = q * t + 0.7107068705f; q = q * t + (-0.142248368f); q = q * t + 0.127414796f; q = q * t;
    const f32x2 s = (v * v) * (-0.72134752044f);
    f32x2 e; e.x = __builtin_amdgcn_exp2f(s.x); e.y = __builtin_amdgcn_exp2f(s.y);
    const f32x2 m = v * (q * e), r = v - m;
    f32x2 o; o.x = v.x < 0.f ? m.x : r.x; o.y = v.y < 0.f ? m.y : r.y; return o;
}
template <int ACT> struct EpiBf16 {
    static constexpr bool PERM = true;
    bf16_t* O; int ldc; const float* bias;
    __device__ __forceinline__ void operator()(const f32x4 (&acc)[2][2][4][2], const Unit& u, int wr, int wc, int fr, int fq) const {
        const int row0 = u.pm * BM + wr * 64 + fr; const int col0 = u.pn * BM + wc * 32 + 8 * fq;
        f32x4 bv[2][2];
#pragma unroll
        for (int bj = 0; bj < 2; ++bj)
#pragma unroll
            for (int n = 0; n < 2; ++n) bv[bj][n] = bias ? *(const f32x4*)(bias + col0 + bj * HALF + 4 * n) : (f32x4){0.f, 0.f, 0.f, 0.f};
#pragma unroll
        for (int ai = 0; ai < 2; ++ai)
#pragma unroll
            for (int m = 0; m < 4; ++m) { bf16_t* rowp = O + (size_t)(row0 + ai * HALF + m * 16) * ldc + col0;
#pragma unroll
                for (int bj = 0; bj < 2; ++bj) { f32x4 v0 = acc[ai][bj][m][0] + bv[bj][0], v1 = acc[ai][bj][m][1] + bv[bj][1];
                    if (ACT == 1) { f32x2 a = gelu_pk((f32x2){v0[0], v0[1]}), b = gelu_pk((f32x2){v0[2], v0[3]}), c = gelu_pk((f32x2){v1[0], v1[1]}), d = gelu_pk((f32x2){v1[2], v1[3]});
                        v0 = (f32x4){a.x, a.y, b.x, b.y}; v1 = (f32x4){c.x, c.y, d.x, d.y}; }
                    u32x4 w; w.x = cvt_pk_bf16(v0[0], v0[1]); w.y = cvt_pk_bf16(v0[2], v0[3]); w.z = cvt_pk_bf16(v1[0], v1[1]); w.w = cvt_pk_bf16(v1[2], v1[3]);
                    *(u32x4*)(rowp + bj * HALF) = w; } }
    }
};
struct EpiSwiGLU {
    static constexpr bool PERM = true;
    bf16_t* O; int ldc;
    __device__ __forceinline__ void operator()(const f32x4 (&acc)[2][2][4][2], const Unit& u, int wr, int wc, int fr, int fq) const {
        const int row0 = u.pm * BM + wr * 64 + fr; const int col0 = u.pn * HALF + wc * 32 + 8 * fq;
#pragma unroll
        for (int ai = 0; ai < 2; ++ai)
#pragma unroll
            for (int m = 0; m < 4; ++m) { bf16_t* rowp = O + (size_t)(row0 + ai * HALF + m * 16) * ldc + col0;
                float r[8];
#pragma unroll
                for (int n = 0; n < 2; ++n)
#pragma unroll
                    for (int j = 0; j < 4; ++j) { const float g = acc[ai][0][m][n][j], up = acc[ai][1][m][n][j]; r[n * 4 + j] = siluf(g) * up; }
                u32x4 w; w.x = cvt_pk_bf16(r[0], r[1]); w.y = cvt_pk_bf16(r[2], r[3]); w.z = cvt_pk_bf16(r[4], r[5]); w.w = cvt_pk_bf16(r[6], r[7]);
                *(u32x4*)rowp = w; }
    }
};

template <class Epi, class Sched>
__device__ __forceinline__ void gemm_phase(const int tidx, LAS unsigned char* lds, const Gemm g, const Sched& S, const Epi& E) {
    const int tid = tidx, wid = __builtin_amdgcn_readfirstlane(tid >> 6), lane = tid & 63, wr = wid >> 2, wc = wid & 3, fr = lane & 15, fq = lane >> 4;
    const int K = g.K, nt = K / BK, lda = g.lda, ldb = g.ldb;
    unsigned voffA[2], voffB[2];
#pragma unroll
    for (int i = 0; i < 2; ++i) { int R, C; stage_rc(tid * 16 + i * 8192, R, C); const int Rb = Epi::PERM ? ((R & ~31) + perm32(R & 31)) : R;
        voffA[i] = (unsigned)(R * lda + C) * 2u; voffB[i] = (unsigned)(Rb * ldb + C) * 2u; }
    const size_t kstep = (size_t)(BK * 2);
    const size_t hstepA = (size_t)HALF * lda * 2, hstepB = (size_t)HALF * ldb * 2;
    const size_t kzstep = (size_t)K * 2;
    const size_t tstepA = 2 * hstepA, tstepB = 2 * hstepB;
    const unsigned ldsw = (unsigned)wid * 1024u;
    const int aoff = lds_byte(wr * 64 + fr, fq * 8), boff = lds_byte(wc * 32 + fr, fq * 8);
#define PG8_SA(b, h) (((b) * 2 + (h)) * HTB)
#define PG8_SB(b, h) ((4 + (b) * 2 + (h)) * HTB)
#define PG8_STAGE(bufoff, gbase, voff) do { _Pragma("unroll") for (int _i = 0; _i < 2; ++_i) \
        __builtin_amdgcn_global_load_lds((const unsigned*)((const char*)(gbase) + (voff)[_i]), (LAS unsigned*)(lds + (bufoff) + ldsw + _i * 8192), 16, 0, 0); } while (0)
#define PG8_LDA(dst, b, h) do { _Pragma("unroll") for (int m = 0; m < 4; ++m) _Pragma("unroll") for (int k = 0; k < 2; ++k) dst[m][k] = *(const LAS bf16x8*)(lds + PG8_SA(b, h) + aoff + m * 2048 + k * 1024); } while (0)
#define PG8_LDB(dst, b, h) do { _Pragma("unroll") for (int n = 0; n < 2; ++n) _Pragma("unroll") for (int k = 0; k < 2; ++k) dst[n][k] = *(const LAS bf16x8*)(lds + PG8_SB(b, h) + boff + n * 2048 + k * 1024); } while (0)
#define PG8_MMA(ai, bj, At, Bt) do { __builtin_amdgcn_s_setprio(1); _Pragma("unroll") for (int m = 0; m < 4; ++m) _Pragma("unroll") for (int n = 0; n < 2; ++n) _Pragma("unroll") for (int k = 0; k < 2; ++k) \
        acc[ai][bj][m][n] = __builtin_amdgcn_mfma_f32_16x16x32_bf16(Bt[n][k], At[m][k], acc[ai][bj][m][n], 0, 0, 0); __builtin_amdgcn_s_setprio(0); } while (0)
#define PG8_WAIT_V(n) asm volatile("s_waitcnt vmcnt(" #n ")" ::: "memory")
#define PG8_WAIT_L(n) asm volatile("s_waitcnt lgkmcnt(" #n ")" ::: "memory")
#define PG8_BAR __builtin_amdgcn_s_barrier()
#define PG8_SCHED __builtin_amdgcn_sched_barrier(0)
    Unit cur, nxt; int ui = 0;
    if (!S.next(0, cur)) return;
    f32x4 acc[2][2][4][2];
#pragma unroll
    for (int a = 0; a < 2; ++a)
#pragma unroll
        for (int b = 0; b < 2; ++b)
#pragma unroll
            for (int m = 0; m < 4; ++m)
#pragma unroll
                for (int n = 0; n < 2; ++n) acc[a][b][m][n] = (f32x4){0.f, 0.f, 0.f, 0.f};
    bf16x8 At[4][2], B0[2][2], B1[2][2];
    const char* cA = (const char*)g.A + (size_t)cur.pm * tstepA + (size_t)cur.kz * kzstep; const char* cB = (const char*)g.Bt + (size_t)cur.pn * tstepB + (size_t)cur.kz * kzstep;
    PG8_STAGE(PG8_SB(0, 0), cB, voffB); PG8_STAGE(PG8_SA(0, 0), cA, voffA); PG8_STAGE(PG8_SB(0, 1), cB + hstepB, voffB); PG8_STAGE(PG8_SA(0, 1), cA + hstepA, voffA);
    if (wr == 1) PG8_BAR;
    PG8_WAIT_V(4); PG8_BAR;
    PG8_STAGE(PG8_SB(1, 0), cB + kstep, voffB); PG8_STAGE(PG8_SA(1, 0), cA + kstep, voffA); PG8_STAGE(PG8_SB(1, 1), cB + hstepB + kstep, voffB);
    PG8_WAIT_V(6); PG8_BAR;
    for (;;) {
        const bool has_next = S.next(ui + 1, nxt);
        const char* nA = has_next ? (const char*)g.A + (size_t)nxt.pm * tstepA + (size_t)nxt.kz * kzstep : cA; const char* nB = has_next ? (const char*)g.Bt + (size_t)nxt.pn * tstepB + (size_t)nxt.kz * kzstep : cB;
        for (int t = 0; t < nt; t += 2) {
            const bool last = (t == nt - 2);
            const char* a1 = cA + (size_t)(t + 1) * kstep;
            const char* a2 = last ? nA : cA + (size_t)(t + 2) * kstep; const char* b2 = last ? nB : cB + (size_t)(t + 2) * kstep;
            const char* a3 = a2 + kstep; const char* b3 = b2 + kstep;
            PG8_LDB(B0, 0, 0); PG8_SCHED; PG8_LDA(At, 0, 0); PG8_STAGE(PG8_SA(1, 1), a1 + hstepA, voffA);
            PG8_WAIT_L(8); PG8_BAR; PG8_WAIT_L(0); PG8_MMA(0, 0, At, B0); PG8_BAR; PG8_SCHED;
            PG8_LDB(B1, 0, 1); PG8_STAGE(PG8_SB(0, 0), b2, voffB);
            PG8_BAR; PG8_WAIT_L(0); PG8_MMA(0, 1, At, B1); PG8_BAR;
            PG8_LDA(At, 0, 1); PG8_STAGE(PG8_SA(0, 0), a2, voffA);
            PG8_BAR; PG8_WAIT_L(0); PG8_MMA(1, 0, At, B0); PG8_BAR; PG8_SCHED;
            PG8_STAGE(PG8_SB(0, 1), b2 + hstepB, voffB);
            PG8_WAIT_V(6); PG8_BAR; PG8_MMA(1, 1, At, B1); PG8_BAR;
            PG8_LDB(B0, 1, 0); PG8_SCHED; PG8_LDA(At, 1, 0); PG8_STAGE(PG8_SA(0, 1), a2 + hstepA, voffA);
            PG8_WAIT_L(8); PG8_BAR; PG8_WAIT_L(0); PG8_MMA(0, 0, At, B0); PG8_BAR; PG8_SCHED;
            PG8_LDB(B1, 1, 1); PG8_STAGE(PG8_SB(1, 0), b3, voffB);
            PG8_BAR; PG8_WAIT_L(0); PG8_MMA(0, 1, At, B1); PG8_BAR;
            PG8_LDA(At, 1, 1); PG8_STAGE(PG8_SA(1, 0), a3, voffA);
            PG8_BAR; PG8_WAIT_L(0); PG8_MMA(1, 0, At, B0); PG8_BAR; PG8_SCHED;
            PG8_STAGE(PG8_SB(1, 1), b3 + hstepB, voffB);
            PG8_WAIT_V(6); PG8_BAR; PG8_MMA(1, 1, At, B1); PG8_BAR;
        }
        E(acc, cur, wr, wc, fr, fq);
        if (!has_next) break;
#pragma unroll
        for (int a = 0; a < 2; ++a)
#pragma unroll
            for (int b = 0; b < 2; ++b)
#pragma unroll
                for (int m = 0; m < 4; ++m)
#pragma unroll
                    for (int n = 0; n < 2; ++n) acc[a][b][m][n] = (f32x4){0.f, 0.f, 0.f, 0.f};
        cur = nxt; cA = nA; cB = nB; ++ui;
    }
    PG8_WAIT_V(0);
    if (wr == 0) PG8_BAR;
    PG8_BAR;
#undef PG8_SA
#undef PG8_SB
#undef PG8_STAGE
#undef PG8_LDA
#undef PG8_LDB
#undef PG8_MMA
#undef PG8_WAIT_V
#undef PG8_WAIT_L
#undef PG8_BAR
#undef PG8_SCHED
}
}

__device__ __forceinline__ void conv_job(const int tidx, LAS float* tile, const float* W, int K, int N, bf16_t* Wt, int Npad, int mode) {
    const int tid = tidx;
    const int tk = K / 128, tn = Npad / 64, nt_all = tk * tn;
    const int nn = tid & 63, kk = tid >> 6, on = tid >> 3, ks = (tid & 7) * 16;
    float v[16];
#define CJ_LOAD(t_) do { const int kt_ = (t_) % tk, nq_ = (t_) / tk, k0_ = kt_ * 128, n0_ = nq_ * 64; \
        const int s0_ = mode ? (((n0_ & 255) >> 7) * DFF + (n0_ >> 8) * 128 + (n0_ & 127)) : n0_; \
        _Pragma("unroll") for (int i = 0; i < 16; ++i) v[i] = (s0_ + nn < N) ? W[(size_t)(k0_ + kk + i * 8) * N + s0_ + nn] : 0.f; } while (0)
    int t = blockIdx.x;
    if (t < nt_all) CJ_LOAD(t);
    for (; t < nt_all; t += gridDim.x) {
        const int kt = t % tk, nq = t / tk, k0 = kt * 128, n0 = nq * 64;
#pragma unroll
        for (int i = 0; i < 16; ++i) tile[(kk + i * 8) * 65 + nn] = v[i];
        __syncthreads();
        if (t + (int)gridDim.x < nt_all) CJ_LOAD(t + (int)gridDim.x);
        float f[16];
#pragma unroll
        for (int i = 0; i < 16; ++i) f[i] = tile[(ks + i) * 65 + on];
        u32x4 w0, w1;
        w0.x = cvt_pk_bf16(f[0], f[1]); w0.y = cvt_pk_bf16(f[2], f[3]); w0.z = cvt_pk_bf16(f[4], f[5]); w0.w = cvt_pk_bf16(f[6], f[7]);
        w1.x = cvt_pk_bf16(f[8], f[9]); w1.y = cvt_pk_bf16(f[10], f[11]); w1.z = cvt_pk_bf16(f[12], f[13]); w1.w = cvt_pk_bf16(f[14], f[15]);
        bf16_t* dst = Wt + (size_t)(n0 + on) * K + k0 + ks;
        *(u32x4*)dst = w0; *(u32x4*)(dst + 8) = w1;
        lds_barrier();
    }
#undef CJ_LOAD
}

__device__ __forceinline__ void row_load(PP p, const float* f, bool first, int row, int lane, f32x4 (&xv)[4], f32x4 (&fv)[4], int nsl) {
    const float* xin = first ? (row < TP ? p->in[0] + (size_t)row * D : p->in[1] + (size_t)(row - TP) * D) : p->out + (size_t)row * D;
#pragma unroll
    for (int i = 0; i < 4; ++i) xv[i] = *(const f32x4*)(xin + lane * 4 + i * 256);
    if (f) {
        if (row < TP) {
#pragma unroll
            for (int i = 0; i < 4; ++i) { const u32x2 w_ = *(const u32x2*)((const bf16_t*)f + (size_t)row * D + lane * 4 + i * 256); fv[i] = (f32x4){bf_lo(w_.x), bf_hi(w_.x), bf_lo(w_.y), bf_hi(w_.y)}; }
        } else {
            const bf16_t* pp = (const bf16_t*)(p->ws + WS_PART) + (size_t)(row - TP) * D + lane * 4;
#pragma unroll
            for (int i = 0; i < 4; ++i) fv[i] = (f32x4){0.f, 0.f, 0.f, 0.f};
            for (int s0 = 0; s0 < nsl; s0 += 6) {
                u32x2 t_[6][4];
#pragma unroll
                for (int u = 0; u < 6; ++u)
#pragma unroll
                    for (int i = 0; i < 4; ++i) t_[u][i] = (s0 + u < nsl) ? *(const u32x2*)(pp + (size_t)(s0 + u) * 1024 * 1024 + i * 256) : (u32x2){0u, 0u};
#pragma unroll
                for (int u = 0; u < 6; ++u)
#pragma unroll
                    for (int i = 0; i < 4; ++i) fv[i] += (f32x4){bf_lo(t_[u][i].x), bf_hi(t_[u][i].x), bf_lo(t_[u][i].y), bf_hi(t_[u][i].y)};
            }
        }
    }
}
__device__ __forceinline__ void row_proc(float* X, bf16_t* H, bool hasf, bool first, bool haspre, float coef, int row, int lane, f32x4 (&xv)[4], const f32x4 (&fv)[4], const f32x4 (&wpo)[4], const f32x4 (&wpr)[4]) {
    if (hasf) {
        float ss = 0.f;
#pragma unroll
        for (int i = 0; i < 4; ++i) ss += fv[i][0] * fv[i][0] + fv[i][1] * fv[i][1] + fv[i][2] * fv[i][2] + fv[i][3] * fv[i][3];
        ss = red64(ss); const float rr = coef * rsqrtf(ss * (1.0f / D) + EPS);
#pragma unroll
        for (int i = 0; i < 4; ++i) xv[i] += fv[i] * wpo[i] * rr;
    }
    if (hasf) {
#pragma unroll
        for (int i = 0; i < 4; ++i) *(f32x4*)(X + (size_t)row * D + lane * 4 + i * 256) = xv[i];
    }
    if (haspre) {
        float ss = 0.f;
#pragma unroll
        for (int i = 0; i < 4; ++i) ss += xv[i][0] * xv[i][0] + xv[i][1] * xv[i][1] + xv[i][2] * xv[i][2] + xv[i][3] * xv[i][3];
        ss = red64(ss); const float rr = rsqrtf(ss * (1.0f / D) + EPS);
#pragma unroll
        for (int i = 0; i < 4; ++i) { const f32x4 hv = xv[i] * wpr[i] * rr;
            u32x2 o; o.x = cvt_pk_bf16(hv[0], hv[1]); o.y = cvt_pk_bf16(hv[2], hv[3]); *(u32x2*)(H + (size_t)row * D + lane * 4 + i * 256) = o; }
    }
}
__device__ __forceinline__ void row_phase(PP p, const int tidx, const float* f, float coef, const float* w_post, const float* w_pre, bool first, int nsl) {
    const int lane = tidx & 63, gw = blockIdx.x * 8 + (tidx >> 6), nw = gridDim.x * 8;
    float* X = p->out; bf16_t* H = (bf16_t*)(p->ws + WS_H);
    f32x4 wpo[4], wpr[4];
#pragma unroll
    for (int i = 0; i < 4; ++i) { wpo[i] = f ? *(const f32x4*)(w_post + lane * 4 + i * 256) : (f32x4){0.f, 0.f, 0.f, 0.f}; wpr[i] = w_pre ? *(const f32x4*)(w_pre + lane * 4 + i * 256) : (f32x4){0.f, 0.f, 0.f, 0.f}; }
    f32x4 xa[4], fa[4], xb[4], fb[4];
    int cur = gw;
    if (cur < T) row_load(p, f, first, cur, lane, xa, fa, nsl);
    while (cur < T) {
        const int nxt = cur + nw;
        if (nxt < T) row_load(p, f, first, nxt, lane, xb, fb, nsl);
        row_proc(X, H, f != nullptr, first, w_pre != nullptr, coef, cur, lane, xa, fa, wpo, wpr);
        if (nxt >= T) break;
        const int nn = nxt + nw;
        if (nn < T) row_load(p, f, first, nn, lane, xa, fa, nsl);
        row_proc(X, H, f != nullptr, first, w_pre != nullptr, coef, nxt, lane, xb, fb, wpo, wpr);
        cur = nn;
    }
}

template <int MODE> __device__ __forceinline__ void prep_phase(PP p, const int tidx, int j) {
    const int lane = tidx & 63, gw = blockIdx.x * 8 + (tidx >> 6), nw = gridDim.x * 8, hh = lane >> 4, eg = lane & 15;
    constexpr int ldp = MODE == 0 ? NGDN : NSSD, choff = MODE == 0 ? 0 : 2048;
    const bf16_t* P = (const bf16_t*)(p->ws + WS_P); float* Q = (float*)(p->ws + WS_Q); float* AB = (float*)(p->ws + WS_AB);
    const float* cw = (MODE == 0 ? p->in[10] : p->in[23]) + (size_t)j * 4 * 3072;
    const float* cb = MODE == 0 ? nullptr : p->in[24] + (size_t)j * 3072;
    const float* cstate = (MODE == 0 ? p->in[3] : p->in[5]) + (size_t)j * 128 * 3 * 3072;
    float* ocp = p->out + (MODE == 0 ? O_GDN_CONV_P : O_SSD_CONV_P) + (size_t)j * 8 * 3 * 3072;
    float* ocs = p->out + (MODE == 0 ? O_GDN_CONV_S : O_SSD_CONV_S) + (size_t)j * 128 * 3 * 3072;
    constexpr int SEG = 17, NSEG = T / SEG;
    static_assert(NSEG * SEG == T, "segments must tile the token rows");
    for (int q = gw; q < NSEG * 6; q += nw) {
        const int seg = q / 6, pass = q - seg * 6;
        const int c = pass * 512 + hh * 128 + eg * 8;
        const int r0 = seg * SEG;
        f32x4 w[4][2], bs[2];
#pragma unroll
        for (int d = 0; d < 4; ++d) { w[d][0] = *(const f32x4*)(cw + d * 3072 + c); w[d][1] = *(const f32x4*)(cw + d * 3072 + c + 4); }
        if (MODE == 1) { bs[0] = *(const f32x4*)(cb + c); bs[1] = *(const f32x4*)(cb + c + 4); } else { bs[0] = (f32x4){0.f, 0.f, 0.f, 0.f}; bs[1] = bs[0]; }
        u32x4 raw[SEG + 3];
#pragma unroll
        for (int i = 0; i < SEG + 3; ++i) { const int r = r0 - 3 + i; raw[i] = (r >= 0) ? *(const u32x4*)(P + (size_t)r * ldp + choff + c) : (u32x4){0u, 0u, 0u, 0u}; }
        float win[3][8];
        unpack8(raw[2], win[0]); unpack8(raw[1], win[1]); unpack8(raw[0], win[2]);
#pragma unroll
        for (int i = 0; i < SEG; ++i) {
            const int row = r0 + i;
            const bool prompt = row < TP;
            const int b = prompt ? (row >> 11) : ((row - TP) >> 3), t = prompt ? (row & 2047) : ((row - TP) & 7), L = prompt ? SEQ : 8;
            float cur[8], acc[8];
            unpack8(raw[3 + i], cur);
#pragma unroll
            for (int e = 0; e < 4; ++e) { acc[e] = cur[e] * w[3][0][e] + bs[0][e]; acc[4 + e] = cur[4 + e] * w[3][1][e] + bs[1][e]; }
#pragma unroll
            for (int d = 1; d <= 3; ++d) {
                float pv[8];
                if (t - d >= 0) {
#pragma unroll
                    for (int e = 0; e < 8; ++e) pv[e] = win[d - 1][e];
                } else if (!prompt) { const float* sp = cstate + ((size_t)b * 3 + (3 + t - d)) * 3072 + c; const f32x4 s0 = *(const f32x4*)sp, s1 = *(const f32x4*)(sp + 4);
#pragma unroll
                    for (int e = 0; e < 4; ++e) { pv[e] = s0[e]; pv[4 + e] = s1[e]; }
                } else {
#pragma unroll
                    for (int e = 0; e < 8; ++e) pv[e] = 0.f;
                }
#pragma unroll
                for (int e = 0; e < 4; ++e) { acc[e] += pv[e] * w[3 - d][0][e]; acc[4 + e] += pv[4 + e] * w[3 - d][1][e]; }
            }
            float ss = 0.f;
#pragma unroll
            for (int e = 0; e < 8; ++e) { acc[e] = siluf(acc[e]); ss += acc[e] * acc[e]; }
            if (MODE == 0 && pass < 4) {
                ss = red16(ss); const float r = rsqrtf(ss + EPS) * (pass < 2 ? 0.08838834764831845f : 1.0f);
#pragma unroll
                for (int e = 0; e < 8; ++e) acc[e] *= r;
            }
            { u32x4 o; o.x = cvt_pk_bf16(acc[0], acc[1]); o.y = cvt_pk_bf16(acc[2], acc[3]); o.z = cvt_pk_bf16(acc[4], acc[5]); o.w = cvt_pk_bf16(acc[6], acc[7]);
                *(u32x4*)((bf16_t*)Q + (size_t)row * 3072 + c) = o; }
            if (t >= L - 3) { float* o = (prompt ? ocp : ocs) + ((size_t)b * 3 + (t - (L - 3))) * 3072 + c;
                *(f32x4*)o = (f32x4){cur[0], cur[1], cur[2], cur[3]}; *(f32x4*)(o + 4) = (f32x4){cur[4], cur[5], cur[6], cur[7]}; }
#pragma unroll
            for (int e = 0; e < 8; ++e) { win[2][e] = win[1][e]; win[1][e] = win[0][e]; win[0][e] = cur[e]; }
        }
    }
    if (MODE == 0) {
        for (int idx = blockIdx.x * 512 + tidx; idx < T * 8; idx += gridDim.x * 512) { const int row = idx >> 3, h = idx & 7;
            const float a_in = __uint_as_float((unsigned)P[(size_t)row * ldp + 4096 + h] << 16), b_in = __uint_as_float((unsigned)P[(size_t)row * ldp + 4104 + h] << 16);
            const float g = -__expf(p->in[11][j * 8 + h]) * softplusf_(a_in + p->in[12][j * 8 + h]);
            AB[(size_t)row * 64 + h] = g; AB[(size_t)row * 64 + 8 + h] = sigmoidf_(b_in); }
    } else {
        for (int idx = blockIdx.x * 512 + tidx; idx < T * 32; idx += gridDim.x * 512) { const int row = idx >> 5, h = idx & 31;
            const float dr = __uint_as_float((unsigned)P[(size_t)row * ldp + 5120 + h] << 16);
            const float dt = softplusf_(dr + p->in[25][j * 32 + h]); const float a = -__expf(p->in[26][j * 32 + h]);
            AB[(size_t)row * 64 + h] = dt * a; AB[(size_t)row * 64 + 32 + h] = dt; }
    }
}

template <int MODE> __device__ __forceinline__ void recur_prompt(PP p, const int tidx, LAS float* Ls, int j) {
    const int tid = tidx, wave = tid >> 6, lane = tid & 63, sub = lane >> 4, eg = lane & 15;
    float* Q = (float*)(p->ws + WS_Q); const float* AB = (const float*)(p->ws + WS_AB); float* F = (float*)(p->ws + WS_F);
    constexpr int BUF = 10304, NCH = SEQ / 32;
    const int ntask = MODE == 0 ? 256 : 512;
    for (int task = blockIdx.x; task < ntask; task += gridDim.x) {
        int b, hd, part, offA, offB, offS, offs0, offs1;
        if (MODE == 0) { b = task >> 5; hd = (task >> 2) & 7; part = task & 3; offA = 1024 + hd * 128; offB = hd * 128; offS = 2048 + hd * 128 + part * 32; offs0 = hd; offs1 = 8 + hd; }
        else { b = task >> 6; hd = (task >> 1) & 31; part = task & 1; const int g = hd >> 3; offA = 2048 + g * 128; offB = 2560 + g * 128; offS = hd * 64 + part * 32; offs0 = hd; offs1 = 32 + hd; }
        const float* Qb = Q + (size_t)b * SEQ * 3072; const float* ABb = AB + (size_t)b * SEQ * 64;
        float* Ob = MODE == 0 ? F + (size_t)b * SEQ * 1024 + hd * 128 + part * 32 : Q + (size_t)b * SEQ * 3072 + offS;
        const int ldo = MODE == 0 ? 1024 : 3072;
        const float dsk = MODE == 1 ? p->in[27][j * 32 + hd] : 0.f;
        float S[8];
#pragma unroll
        for (int i = 0; i < 8; ++i) S[i] = 0.f;
        const int tk = tid >> 4, seg = tid & 15;
        f32x4 kr0, kr1, qr0, qr1; f32x2 vr; float sr = 0.f;
#define RC_LOAD(c) do { const float* r_ = Qb + (size_t)((c) * 32 + tk) * 3072; kr0 = *(const f32x4*)(r_ + offA + seg * 8); kr1 = *(const f32x4*)(r_ + offA + seg * 8 + 4); \
        qr0 = *(const f32x4*)(r_ + offB + seg * 8); qr1 = *(const f32x4*)(r_ + offB + seg * 8 + 4); vr = *(const f32x2*)(r_ + offS + seg * 2); \
        if (tid < 64) sr = ABb[(size_t)((c) * 32 + (tid & 31)) * 64 + (tid < 32 ? offs0 : offs1)]; } while (0)
#define RC_STORE(bf) do { LAS float* B_ = Ls + (bf) * BUF; *(LAS f32x4*)(B_ + tk * 128 + seg * 8) = kr0; *(LAS f32x4*)(B_ + tk * 128 + seg * 8 + 4) = kr1; \
        *(LAS f32x4*)(B_ + 4096 + tk * 128 + seg * 8) = qr0; *(LAS f32x4*)(B_ + 4096 + tk * 128 + seg * 8 + 4) = qr1; *(LAS f32x2*)(B_ + 8192 + tk * 32 + seg * 2) = vr; \
        if (tid < 64) B_[9216 + tid] = sr; } while (0)
        RC_LOAD(0); RC_STORE(0); __syncthreads();
#pragma unroll 1
        for (int c = 0; c < NCH; ++c) {
            if (c + 1 < NCH) RC_LOAD(c + 1);
            LAS float* B_ = Ls + (c & 1) * BUF;
#pragma unroll 4
            for (int tt = 0; tt < 32; ++tt) {
                const f32x4 k0 = *(LAS f32x4*)(B_ + tt * 128 + eg * 8), k1 = *(LAS f32x4*)(B_ + tt * 128 + eg * 8 + 4);
                const f32x4 q0 = *(LAS f32x4*)(B_ + 4096 + tt * 128 + eg * 8), q1 = *(LAS f32x4*)(B_ + 4096 + tt * 128 + eg * 8 + 4);
                const float v = B_[8192 + tt * 32 + wave * 4 + sub], s0 = B_[9216 + tt], s1 = B_[9248 + tt];
                float o;
                if (MODE == 0) {
                    float u = S[0] * k0[0] + S[1] * k0[1] + S[2] * k0[2] + S[3] * k0[3] + S[4] * k1[0] + S[5] * k1[1] + S[6] * k1[2] + S[7] * k1[3];
                    u = red16(u);
                    const float w = s1 * (v - s0 * u);
#pragma unroll
                    for (int i = 0; i < 4; ++i) { S[i] = s0 * S[i] + k0[i] * w; S[4 + i] = s0 * S[4 + i] + k1[i] * w; }
                    o = S[0] * q0[0] + S[1] * q0[1] + S[2] * q0[2] + S[3] * q0[3] + S[4] * q1[0] + S[5] * q1[1] + S[6] * q1[2] + S[7] * q1[3];
                    o = red16(o);
                } else {
                    const float xd = v * s1;
#pragma unroll
                    for (int i = 0; i < 4; ++i) { S[i] = s0 * S[i] + k0[i] * xd; S[4 + i] = s0 * S[4 + i] + k1[i] * xd; }
                    o = S[0] * q0[0] + S[1] * q0[1] + S[2] * q0[2] + S[3] * q0[3] + S[4] * q1[0] + S[5] * q1[1] + S[6] * q1[2] + S[7] * q1[3];
                    o = red16(o) + dsk * v;
                }
                if (eg == 0) B_[9280 + tt * 32 + wave * 4 + sub] = o;
            }
            if (c + 1 < NCH) RC_STORE((c + 1) & 1);
            __syncthreads();
            { const f32x2 ov = *(LAS f32x2*)(B_ + 9280 + tk * 32 + seg * 2); *(f32x2*)(Ob + (size_t)(c * 32 + tk) * ldo + seg * 2) = ov; }
        }
#undef RC_LOAD
#undef RC_STORE
        if (MODE == 0) { float* so = p->out + O_GDN_STATE_P + (((size_t)j * 8 + b) * 8 + hd) * 16384 + part * 32 + wave * 4 + sub;
#pragma unroll
            for (int i = 0; i < 8; ++i) so[(size_t)(eg * 8 + i) * 128] = S[i];
        } else { float* so = p->out + O_SSD_STATE_P + ((((size_t)j * 8 + b) * 32 + hd) * 64 + part * 32 + wave * 4 + sub) * 128 + eg * 8;
            *(f32x4*)so = (f32x4){S[0], S[1], S[2], S[3]}; *(f32x4*)(so + 4) = (f32x4){S[4], S[5], S[6], S[7]}; }
        __syncthreads();
    }
}


__device__ __forceinline__ bf16_t f2bf1(float v) { return (bf16_t)(cvt_pk_bf16(v, 0.f) & 0xffffu); }
__device__ __forceinline__ void ssd_chunked(PP p, const int tidx, LAS unsigned char* lds, int j) {
    const int tid = tidx, wave = __builtin_amdgcn_readfirstlane(tid >> 6), lane = tid & 63, fr = lane & 15, fq = lane >> 4;
    bf16_t* Q = (bf16_t*)(p->ws + WS_Q); const float* AB = (const float*)(p->ws + WS_AB);
    LAS bf16_t* Cs = (LAS bf16_t*)(lds); LAS bf16_t* Bs = (LAS bf16_t*)(lds + 17408); LAS bf16_t* Ss = (LAS bf16_t*)(lds + 34816);
    LAS bf16_t* BT = (LAS bf16_t*)(lds + 52224); LAS bf16_t* XdtT = (LAS bf16_t*)(lds + 70656); LAS bf16_t* XdT = (LAS bf16_t*)(lds + 79872);
    LAS bf16_t* Ms = (LAS bf16_t*)(lds + 89088); LAS float* Gs = (LAS float*)(lds + 98304);
    constexpr int NCH = SEQ / 64;
    for (int task = blockIdx.x; task < 256; task += gridDim.x) {
        const int xcd_ = task & 7, slot_ = task >> 3, grp_ = xcd_ * 4 + (slot_ >> 3);
        const int b = grp_ >> 2, g = grp_ & 3, hd = g * 8 + (slot_ & 7);
        bf16_t* Qb = Q + (size_t)b * SEQ * 3072; const float* ABb = AB + (size_t)b * SEQ * 64;
        const float dsk = p->in[27][j * 32 + hd];
        f32x4 Sacc[4];
#pragma unroll
        for (int t = 0; t < 4; ++t) Sacc[t] = (f32x4){0.f, 0.f, 0.f, 0.f};
        for (int i = tid; i < 17408 / 4; i += 512) ((LAS unsigned*)Ss)[i] = 0u;
        struct SCRegs { u32x4 rb[2], rc[2], rx; float rla, rdt; };
        SCRegs rs[2];
#define SC_LOAD(c, R) do { const bf16_t* row_ = Qb + (size_t)((c) * 64 + lane) * 3072; \
        (R).rb[0] = *(const u32x4*)(row_ + 2048 + g * 128 + wave * 16); (R).rb[1] = *(const u32x4*)(row_ + 2048 + g * 128 + wave * 16 + 8); \
        (R).rc[0] = *(const u32x4*)(row_ + 2560 + g * 128 + wave * 16); (R).rc[1] = *(const u32x4*)(row_ + 2560 + g * 128 + wave * 16 + 8); \
        (R).rx = *(const u32x4*)(row_ + hd * 64 + wave * 8); \
        (R).rla = ABb[(size_t)((c) * 64 + lane) * 64 + hd]; (R).rdt = ABb[(size_t)((c) * 64 + lane) * 64 + 32 + hd]; } while (0)
        SC_LOAD(0, rs[0]); SC_LOAD(1, rs[1]);
#pragma unroll 1
        for (int c0 = 0; c0 < NCH; c0 += 2) {
#pragma unroll
        for (int u_ = 0; u_ < 2; ++u_) {
            const int c = c0 + u_; SCRegs& R = rs[u_];
            const u32x4 rb0 = R.rb[0], rb1 = R.rb[1], rc0 = R.rc[0], rc1 = R.rc[1], rxw = R.rx; const float rla = R.rla, rdt = R.rdt;
            float G = rla;
#pragma unroll
            for (int d = 1; d < 64; d <<= 1) { const float t_ = __shfl_up(G, d); if (lane >= d) G += t_; }
            const float Glast = __shfl(G, 63); const float dtj = rdt; const float ed = __expf(Glast - G) * dtj;
            { *(LAS u32x4*)(Bs + lane * 136 + wave * 16) = rb0; *(LAS u32x4*)(Bs + lane * 136 + wave * 16 + 8) = rb1;
              const unsigned ww[8] = {rb0.x, rb0.y, rb0.z, rb0.w, rb1.x, rb1.y, rb1.z, rb1.w};
#pragma unroll
              for (int e = 0; e < 8; ++e) { BT[(wave * 16 + 2 * e) * 72 + lane] = (bf16_t)(ww[e] & 0xffffu); BT[(wave * 16 + 2 * e + 1) * 72 + lane] = (bf16_t)(ww[e] >> 16); }
              *(LAS u32x4*)(Cs + lane * 136 + wave * 16) = rc0; *(LAS u32x4*)(Cs + lane * 136 + wave * 16 + 8) = rc1; }
            { float xf[8]; unpack8(rxw, xf);
#pragma unroll
              for (int e = 0; e < 8; ++e) { XdtT[(wave * 8 + e) * 72 + lane] = f2bf1(xf[e] * dtj); XdT[(wave * 8 + e) * 72 + lane] = f2bf1(xf[e] * ed); } }
            if (wave == 0) Gs[lane] = G;
            if (c + 2 < NCH) SC_LOAD(c + 2, R);
            lds_barrier();
            const int ti = wave >> 1, th = (wave & 1) * 2;
            f32x4 yacc[2], cb[2];
#pragma unroll
            for (int t = 0; t < 2; ++t) { yacc[t] = (f32x4){0.f, 0.f, 0.f, 0.f}; cb[t] = (f32x4){0.f, 0.f, 0.f, 0.f}; }
#pragma unroll
            for (int ks = 0; ks < 4; ++ks) {
                const bf16x8 a = *(const LAS bf16x8*)(Cs + (ti * 16 + fr) * 136 + ks * 32 + fq * 8);
#pragma unroll
                for (int t = 0; t < 2; ++t) {
                    const bf16x8 sb = *(const LAS bf16x8*)(Ss + ((th + t) * 16 + fr) * 136 + ks * 32 + fq * 8);
                    const bf16x8 bb = *(const LAS bf16x8*)(Bs + ((th + t) * 16 + fr) * 136 + ks * 32 + fq * 8);
                    yacc[t] = __builtin_amdgcn_mfma_f32_16x16x32_bf16(a, sb, yacc[t], 0, 0, 0);
                    cb[t] = __builtin_amdgcn_mfma_f32_16x16x32_bf16(a, bb, cb[t], 0, 0, 0);
                }
            }
            float gi[4];
#pragma unroll
            for (int jj = 0; jj < 4; ++jj) gi[jj] = Gs[ti * 16 + fq * 4 + jj];
#pragma unroll
            for (int t = 0; t < 2; ++t) {
                const int jc = (th + t) * 16 + fr; const float gj = Gs[jc];
#pragma unroll
                for (int jj = 0; jj < 4; ++jj) { const int i = ti * 16 + fq * 4 + jj;
                    yacc[t][jj] *= __expf(gi[jj]);
                    const float mv = (jc <= i) ? cb[t][jj] * __expf(gi[jj] - gj) : 0.f;
                    Ms[i * 72 + jc] = f2bf1(mv); }
            }
            lds_barrier();
#pragma unroll
            for (int ks = 0; ks < 2; ++ks) {
                const bf16x8 a = *(const LAS bf16x8*)(Ms + (ti * 16 + fr) * 72 + ks * 32 + fq * 8);
#pragma unroll
                for (int t = 0; t < 2; ++t) { const bf16x8 xb = *(const LAS bf16x8*)(XdtT + ((th + t) * 16 + fr) * 72 + ks * 32 + fq * 8);
                    yacc[t] = __builtin_amdgcn_mfma_f32_16x16x32_bf16(a, xb, yacc[t], 0, 0, 0); }
            }
#pragma unroll
            for (int t = 0; t < 2; ++t)
#pragma unroll
                for (int jj = 0; jj < 4; ++jj) { bf16_t* addr = Qb + (size_t)(c * 64 + ti * 16 + fq * 4 + jj) * 3072 + hd * 64 + (th + t) * 16 + fr; const float xv = __uint_as_float((unsigned)*addr << 16); *addr = f2bf1(yacc[t][jj] + dsk * xv); }
            const float eL = __expf(Glast); const int tn0 = (wave & 1) * 4;
#pragma unroll
            for (int t = 0; t < 4; ++t) Sacc[t] *= eL;
#pragma unroll
            for (int ks = 0; ks < 2; ++ks) {
                const bf16x8 a = *(const LAS bf16x8*)(XdT + (ti * 16 + fr) * 72 + ks * 32 + fq * 8);
#pragma unroll
                for (int t = 0; t < 4; ++t) { const bf16x8 bb = *(const LAS bf16x8*)(BT + ((tn0 + t) * 16 + fr) * 72 + ks * 32 + fq * 8);
                    Sacc[t] = __builtin_amdgcn_mfma_f32_16x16x32_bf16(a, bb, Sacc[t], 0, 0, 0); }
            }
#pragma unroll
            for (int t = 0; t < 4; ++t)
#pragma unroll
                for (int jj = 0; jj < 4; ++jj) Ss[(ti * 16 + fq * 4 + jj) * 136 + (tn0 + t) * 16 + fr] = f2bf1(Sacc[t][jj]);
            lds_barrier();
        }
        }
#undef SC_LOAD
        { const int tn0 = (wave & 1) * 4, ti = wave >> 1;
          float* so = p->out + O_SSD_STATE_P + (((size_t)j * 8 + b) * 32 + hd) * 64 * 128;
#pragma unroll
          for (int t = 0; t < 4; ++t)
#pragma unroll
              for (int jj = 0; jj < 4; ++jj) so[(size_t)(ti * 16 + fq * 4 + jj) * 128 + (tn0 + t) * 16 + fr] = Sacc[t][jj]; }
    }
}

__device__ __forceinline__ void gdn_r1(PP p, const int tidx, LAS unsigned char* lds, int j) {
    const int tid = tidx, wave = __builtin_amdgcn_readfirstlane(tid >> 6), lane = tid & 63, fr = lane & 15, fq = lane >> 4;
    bf16_t* Q16 = (bf16_t*)(p->ws + WS_Q); bf16_t* P = (bf16_t*)(p->ws + WS_P); float* AB = (float*)(p->ws + WS_AB);
    LAS bf16_t* Ks = (LAS bf16_t*)(lds); LAS bf16_t* Qs = (LAS bf16_t*)(lds + 17408); LAS float* Mf = (LAS float*)(lds + 34816);
    LAS float* RHS = (LAS float*)(lds + 51200); LAS float* Gs = (LAS float*)(lds + 116736); LAS float* Bts = (LAS float*)(lds + 116992);
    u32x4 q0, q1, k0, k1, v0, v1; float gl = 0.f, bt = 0.f;
#define R1_LOAD(task_) do { const int z_ = (task_) & 31, h_ = ((task_) >> 5) & 7, b_ = (task_) >> 8; const size_t rb_ = (size_t)b_ * SEQ + z_ * 64; \
        const bf16_t* rp_ = Q16 + (rb_ + lane) * 3072 + h_ * 128 + wave * 16; \
        q0 = *(const u32x4*)rp_; q1 = *(const u32x4*)(rp_ + 8); k0 = *(const u32x4*)(rp_ + 1024); k1 = *(const u32x4*)(rp_ + 1032); v0 = *(const u32x4*)(rp_ + 2048); v1 = *(const u32x4*)(rp_ + 2056); \
        gl = AB[(rb_ + lane) * 64 + h_]; bt = AB[(rb_ + lane) * 64 + 8 + h_]; } while (0)
    if (blockIdx.x < 2048) R1_LOAD(blockIdx.x);
    for (int task = blockIdx.x; task < 2048; task += gridDim.x) {
        const int z = task & 31, h = (task >> 5) & 7, b = task >> 8;
        const size_t rowbase = (size_t)b * SEQ + z * 64;
        {
            bf16_t* rp = Q16 + (rowbase + lane) * 3072 + h * 128 + wave * 16;
            float G = gl;
#pragma unroll
            for (int d = 1; d < 64; d <<= 1) { const float t_ = __shfl_up(G, d); if (lane >= d) G += t_; }
            const float Glast = __shfl(G, 63); const float eG = __expf(G), eD = __expf(Glast - G);
            *(LAS u32x4*)(Ks + lane * 136 + wave * 16) = k0; *(LAS u32x4*)(Ks + lane * 136 + wave * 16 + 8) = k1;
            *(LAS u32x4*)(Qs + lane * 136 + wave * 16) = q0; *(LAS u32x4*)(Qs + lane * 136 + wave * 16 + 8) = q1;
            float qf[16], kf[16], vf[16];
            unpack8(q0, qf); unpack8(q1, qf + 8); unpack8(k0, kf); unpack8(k1, kf + 8); unpack8(v0, vf); unpack8(v1, vf + 8);
            const float bg = bt * eG;
#pragma unroll
            for (int e = 0; e < 16; e += 4) {
                *(LAS f32x4*)(RHS + lane * 256 + wave * 16 + e) = (f32x4){vf[e] * bt, vf[e + 1] * bt, vf[e + 2] * bt, vf[e + 3] * bt};
                *(LAS f32x4*)(RHS + lane * 256 + 128 + wave * 16 + e) = (f32x4){kf[e] * bg, kf[e + 1] * bg, kf[e + 2] * bg, kf[e + 3] * bg};
            }
            u32x4 o0, o1;
            o0.x = cvt_pk_bf16(qf[0] * eG, qf[1] * eG); o0.y = cvt_pk_bf16(qf[2] * eG, qf[3] * eG); o0.z = cvt_pk_bf16(qf[4] * eG, qf[5] * eG); o0.w = cvt_pk_bf16(qf[6] * eG, qf[7] * eG);
            o1.x = cvt_pk_bf16(qf[8] * eG, qf[9] * eG); o1.y = cvt_pk_bf16(qf[10] * eG, qf[11] * eG); o1.z = cvt_pk_bf16(qf[12] * eG, qf[13] * eG); o1.w = cvt_pk_bf16(qf[14] * eG, qf[15] * eG);
            *(u32x4*)rp = o0; *(u32x4*)(rp + 8) = o1;
            o0.x = cvt_pk_bf16(kf[0] * eD, kf[1] * eD); o0.y = cvt_pk_bf16(kf[2] * eD, kf[3] * eD); o0.z = cvt_pk_bf16(kf[4] * eD, kf[5] * eD); o0.w = cvt_pk_bf16(kf[6] * eD, kf[7] * eD);
            o1.x = cvt_pk_bf16(kf[8] * eD, kf[9] * eD); o1.y = cvt_pk_bf16(kf[10] * eD, kf[11] * eD); o1.z = cvt_pk_bf16(kf[12] * eD, kf[13] * eD); o1.w = cvt_pk_bf16(kf[14] * eD, kf[15] * eD);
            *(u32x4*)(rp + 1024) = o0; *(u32x4*)(rp + 1032) = o1;
            if (wave == 0) { Gs[lane] = G; Bts[lane] = bt; ((float*)(p->ws + WS_G))[(size_t)(b * 8 + h) * SEQ + z * 64 + lane] = G; }
        }
        __syncthreads();
        {
            const int ti = wave >> 1, th = (wave & 1) * 2;
            f32x4 kk[2], qk[2];
#pragma unroll
            for (int t = 0; t < 2; ++t) { kk[t] = (f32x4){0.f, 0.f, 0.f, 0.f}; qk[t] = (f32x4){0.f, 0.f, 0.f, 0.f}; }
#pragma unroll
            for (int ks = 0; ks < 4; ++ks) {
                const bf16x8 ak = *(const LAS bf16x8*)(Ks + (ti * 16 + fr) * 136 + ks * 32 + fq * 8), aq = *(const LAS bf16x8*)(Qs + (ti * 16 + fr) * 136 + ks * 32 + fq * 8);
#pragma unroll
                for (int t = 0; t < 2; ++t) { const bf16x8 bk = *(const LAS bf16x8*)(Ks + ((th + t) * 16 + fr) * 136 + ks * 32 + fq * 8);
                    kk[t] = __builtin_amdgcn_mfma_f32_16x16x32_bf16(ak, bk, kk[t], 0, 0, 0); qk[t] = __builtin_amdgcn_mfma_f32_16x16x32_bf16(aq, bk, qk[t], 0, 0, 0); }
            }
#pragma unroll
            for (int t = 0; t < 2; ++t) { const int jc = (th + t) * 16 + fr; const float gj = Gs[jc];
#pragma unroll
                for (int jj = 0; jj < 4; ++jj) { const int i = ti * 16 + fq * 4 + jj; const float dec = __expf(fminf(Gs[i] - gj, 0.f));
                    Mf[i * 64 + jc] = (jc < i) ? Bts[i] * kk[t][jj] * dec : 0.f;
                    P[(rowbase + i) * NGDN + h * 64 + jc] = f2bf1((jc <= i) ? qk[t][jj] * dec : 0.f); } }
        }
        __syncthreads();
        if (task + (int)gridDim.x < 2048) R1_LOAD(task + (int)gridDim.x);
        if (tid < 256) {
            const int col = tid;
            f32x2 xp[32];
#pragma unroll
            for (int i = 0; i < 32; ++i) { xp[i].x = RHS[(2 * i) * 256 + col]; xp[i].y = RHS[(2 * i + 1) * 256 + col]; }
#pragma unroll
            for (int i = 1; i < 64; ++i) {
                f32x2 sa = {0.f, 0.f}, sb = {0.f, 0.f}, sc = {0.f, 0.f}, sd = {0.f, 0.f};
#pragma unroll
                for (int j4 = 0; j4 < (i + 3) / 4; ++j4) { const f32x4 m = *(const LAS f32x4*)(Mf + i * 64 + j4 * 4);
                    const f32x2 m01 = {m[0], m[1]}, m23 = {m[2], m[3]};
                    if (j4 & 1) { sc = __builtin_elementwise_fma(m01, xp[j4 * 2], sc); sd = __builtin_elementwise_fma(m23, xp[j4 * 2 + 1], sd); }
                    else { sa = __builtin_elementwise_fma(m01, xp[j4 * 2], sa); sb = __builtin_elementwise_fma(m23, xp[j4 * 2 + 1], sb); } }
                const f32x2 st = (sa + sb) + (sc + sd);
                if (i & 1) xp[i >> 1].y -= st.x + st.y; else xp[i >> 1].x -= st.x + st.y;
            }
            float x[64];
#pragma unroll
            for (int i = 0; i < 32; ++i) { x[2 * i] = xp[i].x; x[2 * i + 1] = xp[i].y; }
            if (col < 128) { bf16_t* up = Q16 + rowbase * 3072 + 2048 + h * 128 + col;
#pragma unroll
                for (int i = 0; i < 64; ++i) up[(size_t)i * 3072] = f2bf1(x[i]); }
            else { bf16_t* wp = P + rowbase * NGDN + 512 + h * 128 + (col - 128);
#pragma unroll
                for (int i = 0; i < 64; ++i) wp[(size_t)i * NGDN] = f2bf1(-x[i]); }
        }
        __syncthreads();
    }
#undef R1_LOAD
}

__device__ __forceinline__ void gdn_r2(PP p, const int tidx, LAS unsigned char* lds, int j) {
    const int tid = tidx, wave = __builtin_amdgcn_readfirstlane(tid >> 6), lane = tid & 63, fr = lane & 15, fq = lane >> 4;
    const bf16_t* Q16 = (const bf16_t*)(p->ws + WS_Q); const bf16_t* P = (const bf16_t*)(p->ws + WS_P); const float* AB = (const float*)(p->ws + WS_AB); float* F = (float*)(p->ws + WS_F);
    LAS bf16_t* Wn = (LAS bf16_t*)(lds); LAS bf16_t* QDs = (LAS bf16_t*)(lds + 17408); LAS bf16_t* KDT = (LAS bf16_t*)(lds + 34816);
    LAS bf16_t* ATs = (LAS bf16_t*)(lds + 53248); LAS bf16_t* ST = (LAS bf16_t*)(lds + 62464); LAS bf16_t* VT = (LAS bf16_t*)(lds + 71168);
    const int ti = wave >> 1, te = wave & 1, lr = tid >> 4, lsg = tid & 15;
    for (int task = blockIdx.x; task < 256; task += gridDim.x) {
        const int xcd_ = task & 7, slot_ = task >> 3, bh_ = xcd_ * 8 + (slot_ >> 2);
        const int dvb = slot_ & 3, h = bh_ & 7, b = bh_ >> 3;
        f32x4 Sacc[2];
        Sacc[0] = (f32x4){0.f, 0.f, 0.f, 0.f}; Sacc[1] = (f32x4){0.f, 0.f, 0.f, 0.f};
        for (int i = tid; i < 8704 / 4; i += 512) ((LAS unsigned*)ST)[i] = 0u;
        struct R2Regs { u32x4 rw0, rw1, rq0, rq1, rk0, rk1, ra; unsigned short ru[4]; float rg; };
        R2Regs rs[2];
#define R2_LOAD(c, R) do { const size_t rb_ = (size_t)b * SEQ + (c) * 64; \
        { const bf16_t* pp_ = P + (rb_ + lr) * NGDN + 512 + h * 128 + lsg * 8; const bf16_t* qq_ = Q16 + (rb_ + lr) * 3072 + h * 128 + lsg * 8; \
          (R).rw0 = *(const u32x4*)pp_; (R).rw1 = *(const u32x4*)(pp_ + (size_t)32 * NGDN); (R).rq0 = *(const u32x4*)qq_; (R).rq1 = *(const u32x4*)(qq_ + (size_t)32 * 3072); \
          (R).rk0 = *(const u32x4*)(qq_ + 1024); (R).rk1 = *(const u32x4*)(qq_ + 1024 + (size_t)32 * 3072); } \
        (R).ra = *(const u32x4*)(P + (rb_ + (tid >> 3)) * NGDN + h * 64 + (tid & 7) * 8); \
        _Pragma("unroll") for (int jj = 0; jj < 4; ++jj) (R).ru[jj] = Q16[(rb_ + ti * 16 + fq * 4 + jj) * 3072 + 2048 + h * 128 + dvb * 32 + te * 16 + fr]; \
        (R).rg = ((const float*)(p->ws + WS_G))[(size_t)(b * 8 + h) * SEQ + (c) * 64 + 63]; } while (0)
        R2_LOAD(0, rs[0]); R2_LOAD(1, rs[1]);
#pragma unroll 1
        for (int c0 = 0; c0 < SEQ / 64; c0 += 2) {
#pragma unroll
        for (int u_ = 0; u_ < 2; ++u_) {
            const int c = c0 + u_; R2Regs& R = rs[u_];
            const u32x4 rw0 = R.rw0, rw1 = R.rw1, rq0 = R.rq0, rq1 = R.rq1, rk0 = R.rk0, rk1 = R.rk1, ra = R.ra; const float rg = R.rg;
            unsigned short ru[4];
#pragma unroll
            for (int jj = 0; jj < 4; ++jj) ru[jj] = R.ru[jj];
            *(LAS u32x4*)(Wn + lr * 136 + lsg * 8) = rw0; *(LAS u32x4*)(Wn + (lr + 32) * 136 + lsg * 8) = rw1;
            *(LAS u32x4*)(QDs + lr * 136 + lsg * 8) = rq0; *(LAS u32x4*)(QDs + (lr + 32) * 136 + lsg * 8) = rq1;
            *(LAS u32x4*)(KDT + lr * 136 + lsg * 8) = rk0; *(LAS u32x4*)(KDT + (lr + 32) * 136 + lsg * 8) = rk1;
            *(LAS u32x4*)(ATs + (tid >> 3) * 72 + (tid & 7) * 8) = ra;
            f32x4 vacc, oacc = (f32x4){0.f, 0.f, 0.f, 0.f};
#pragma unroll
            for (int jj = 0; jj < 4; ++jj) vacc[jj] = __uint_as_float((unsigned)ru[jj] << 16);
            const float gtot = __expf(rg);
            if (c + 2 < SEQ / 64) R2_LOAD(c + 2, R);
            lds_barrier();
#pragma unroll
            for (int ks = 0; ks < 4; ++ks) {
                const bf16x8 sb = *(const LAS bf16x8*)(ST + (te * 16 + fr) * 136 + ks * 32 + fq * 8);
                const bf16x8 aw = *(const LAS bf16x8*)(Wn + (ti * 16 + fr) * 136 + ks * 32 + fq * 8), aq = *(const LAS bf16x8*)(QDs + (ti * 16 + fr) * 136 + ks * 32 + fq * 8);
                vacc = __builtin_amdgcn_mfma_f32_16x16x32_bf16(aw, sb, vacc, 0, 0, 0); oacc = __builtin_amdgcn_mfma_f32_16x16x32_bf16(aq, sb, oacc, 0, 0, 0);
            }
            { u32x2 w; w.x = cvt_pk_bf16(vacc[0], vacc[1]); w.y = cvt_pk_bf16(vacc[2], vacc[3]); *(LAS u32x2*)(VT + (te * 16 + fr) * 72 + ti * 16 + fq * 4) = w; }
            lds_barrier();
#pragma unroll
            for (int ks = 0; ks < 2; ++ks) {
                const bf16x8 aa = *(const LAS bf16x8*)(ATs + (ti * 16 + fr) * 72 + ks * 32 + fq * 8), vb = *(const LAS bf16x8*)(VT + (te * 16 + fr) * 72 + ks * 32 + fq * 8);
                oacc = __builtin_amdgcn_mfma_f32_16x16x32_bf16(aa, vb, oacc, 0, 0, 0);
            }
#pragma unroll
            for (int jj = 0; jj < 4; ++jj) ((bf16_t*)F)[((size_t)b * SEQ + c * 64 + ti * 16 + fq * 4 + jj) * 1024 + h * 128 + dvb * 32 + te * 16 + fr] = f2bf1(oacc[jj]);
            Sacc[0] *= gtot; Sacc[1] *= gtot;
#pragma unroll
            for (int ks = 0; ks < 2; ++ks) {
                bf16x8 ak;
#pragma unroll
                for (int e = 0; e < 8; ++e) ak[e] = (short)KDT[(ks * 32 + fq * 8 + e) * 136 + wave * 16 + fr];
#pragma unroll
                for (int t = 0; t < 2; ++t) { const bf16x8 vb = *(const LAS bf16x8*)(VT + (t * 16 + fr) * 72 + ks * 32 + fq * 8); Sacc[t] = __builtin_amdgcn_mfma_f32_16x16x32_bf16(ak, vb, Sacc[t], 0, 0, 0); }
            }
#pragma unroll
            for (int t = 0; t < 2; ++t) { u32x2 w; w.x = cvt_pk_bf16(Sacc[t][0], Sacc[t][1]); w.y = cvt_pk_bf16(Sacc[t][2], Sacc[t][3]); *(LAS u32x2*)(ST + (t * 16 + fr) * 136 + wave * 16 + fq * 4) = w; }
            lds_barrier();
        }
        }
#undef R2_LOAD
        float* so = p->out + O_GDN_STATE_P + (((size_t)j * 8 + b) * 8 + h) * 16384 + dvb * 32;
#pragma unroll
        for (int t = 0; t < 2; ++t)
#pragma unroll
            for (int jj = 0; jj < 4; ++jj) so[(size_t)(wave * 16 + fq * 4 + jj) * 128 + t * 16 + fr] = Sacc[t][jj];
    }
}

__device__ __forceinline__ void gdn_sample(PP p, const int tidx, LAS float* Ls, int j) {
    const int tid = tidx, wave = tid >> 6, lane = tid & 63, rgq = lane & 3, cc = lane >> 2, col = wave * 16 + cc;
    const bf16_t* Q16 = (const bf16_t*)(p->ws + WS_Q); const float* AB = (const float*)(p->ws + WS_AB); float* F = (float*)(p->ws + WS_F);
    struct GRegs { float S[32]; float vv[8], aa[8], bb[8]; u32x2 kq; };
    GRegs rs[2];
    const int kt = (tid & 255) >> 5, ksg = tid & 31, koff = tid < 256 ? 1024 : 0, kdst = (tid < 256 ? 0 : 1024) + kt * 128 + ksg * 4;
#define GS_LOAD(task, R) do { const int b_ = (task) >> 3, h_ = (task) & 7, r0_ = TP + b_ * 8; \
        const float* sin_ = p->in[2] + (((size_t)j * 128 + b_) * 8 + h_) * 16384 + (size_t)(rgq * 32) * 128 + col; \
        _Pragma("unroll") for (int i = 0; i < 32; ++i) (R).S[i] = sin_[(size_t)i * 128]; \
        _Pragma("unroll") for (int t = 0; t < 8; ++t) { (R).vv[t] = __uint_as_float((unsigned)Q16[(size_t)(r0_ + t) * 3072 + 2048 + h_ * 128 + col] << 16); (R).aa[t] = AB[(size_t)(r0_ + t) * 64 + h_]; (R).bb[t] = AB[(size_t)(r0_ + t) * 64 + 8 + h_]; } \
        (R).kq = *(const u32x2*)(Q16 + (size_t)(r0_ + kt) * 3072 + koff + h_ * 128 + ksg * 4); } while (0)
    const int G = gridDim.x, t0 = blockIdx.x;
    __syncthreads();
    if (t0 < 1024) GS_LOAD(t0, rs[0]);
    if (t0 + G < 1024) GS_LOAD(t0 + G, rs[1]);
#pragma unroll 1
    for (int tb = t0; tb < 1024; tb += 2 * G) {
#pragma unroll
        for (int u_ = 0; u_ < 2; ++u_) {
            const int task = tb + u_ * G;
            if (task < 1024) {
                GRegs& R = rs[u_];
                const int b = task >> 3, h = task & 7; const int r0 = TP + b * 8;
                float S[32], vv[8], aa[8], bb[8];
#pragma unroll
                for (int i = 0; i < 32; ++i) S[i] = R.S[i];
#pragma unroll
                for (int t = 0; t < 8; ++t) { vv[t] = R.vv[t]; aa[t] = __expf(R.aa[t]); bb[t] = R.bb[t]; }
                { const u32x2 w_ = R.kq; *(LAS f32x4*)(Ls + kdst) = (f32x4){bf_lo(w_.x), bf_hi(w_.x), bf_lo(w_.y), bf_hi(w_.y)}; }
                if (task + 2 * G < 1024) GS_LOAD(task + 2 * G, R);
                lds_barrier();
#pragma unroll
                for (int t = 0; t < 8; ++t) {
                    float u = 0.f;
#pragma unroll
                    for (int i = 0; i < 8; ++i) { const f32x4 k4 = *(const LAS f32x4*)(Ls + t * 128 + rgq * 32 + i * 4); u += S[i * 4] * k4[0] + S[i * 4 + 1] * k4[1] + S[i * 4 + 2] * k4[2] + S[i * 4 + 3] * k4[3]; }
                    u = red4(u);
                    const float av = aa[t], w = bb[t] * (vv[t] - av * u);
                    float o = 0.f;
#pragma unroll
                    for (int i = 0; i < 8; ++i) { const f32x4 k4 = *(const LAS f32x4*)(Ls + t * 128 + rgq * 32 + i * 4); const f32x4 q4 = *(const LAS f32x4*)(Ls + 1024 + t * 128 + rgq * 32 + i * 4);
#pragma unroll
                        for (int e = 0; e < 4; ++e) { S[i * 4 + e] = av * S[i * 4 + e] + k4[e] * w; o += S[i * 4 + e] * q4[e]; } }
                    o = red4(o);
                    if (rgq == 0) ((bf16_t*)F)[(size_t)(r0 + t) * 1024 + h * 128 + col] = f2bf1(o);
                }
                float* so = p->out + O_GDN_STATE_S + (((size_t)j * 128 + b) * 8 + h) * 16384 + (size_t)(rgq * 32) * 128 + col;
#pragma unroll
                for (int i = 0; i < 32; ++i) so[(size_t)i * 128] = S[i];
                lds_barrier();
            }
        }
    }
#undef GS_LOAD
}

__device__ __forceinline__ void ssd_sample(PP p, const int tidx, LAS float* Ls, int j) {
    const int tid = tidx, wave = tid >> 6, lane = tid & 63, r8 = lane >> 3, ng = lane & 7, pr = wave * 8 + r8;
    bf16_t* Q = (bf16_t*)(p->ws + WS_Q); const float* AB = (const float*)(p->ws + WS_AB);
    struct SRegs { f32x4 S[4]; float x[8], la[8], dt[8]; u32x4 bc; float dsk; };
    SRegs rs[2];
    const int bt = (tid >> 5) & 7, bwhich = (tid >> 4) & 1, bseg = tid & 15;
#define SS_LOAD(task, R) do { const int b_ = (task) >> 5, hd_ = (task) & 31, g_ = hd_ >> 3, r0_ = TP + b_ * 8; \
        const float* sin_ = p->in[4] + ((((size_t)j * 128 + b_) * 32 + hd_) * 64 + pr) * 128 + ng * 4; \
        _Pragma("unroll") for (int i = 0; i < 4; ++i) (R).S[i] = *(const f32x4*)(sin_ + i * 32); \
        _Pragma("unroll") for (int t = 0; t < 8; ++t) { (R).x[t] = __uint_as_float((unsigned)Q[(size_t)(r0_ + t) * 3072 + hd_ * 64 + pr] << 16); (R).la[t] = AB[(size_t)(r0_ + t) * 64 + hd_]; (R).dt[t] = AB[(size_t)(r0_ + t) * 64 + 32 + hd_]; } \
        (R).bc = *(const u32x4*)(Q + (size_t)(r0_ + bt) * 3072 + 2048 + bwhich * 512 + g_ * 128 + bseg * 8); (R).dsk = p->in[27][j * 32 + hd_]; } while (0)
    const int G = gridDim.x, t0 = blockIdx.x;
    __syncthreads();
    if (t0 < 4096) SS_LOAD(t0, rs[0]);
    if (t0 + G < 4096) SS_LOAD(t0 + G, rs[1]);
#pragma unroll 1
    for (int tb = t0; tb < 4096; tb += 2 * G) {
#pragma unroll
        for (int u_ = 0; u_ < 2; ++u_) {
            const int task = tb + u_ * G;
            if (task < 4096) {
                SRegs& R = rs[u_];
                const int b = task >> 5, hd = task & 31; const int r0 = TP + b * 8;
                f32x4 S[4]; float xs[8], las[8], dts[8];
#pragma unroll
                for (int i = 0; i < 4; ++i) S[i] = R.S[i];
#pragma unroll
                for (int t = 0; t < 8; ++t) { xs[t] = R.x[t]; las[t] = R.la[t]; dts[t] = R.dt[t]; }
                const float dsk = R.dsk;
                if (tid < 256) { float bf_[8]; unpack8(R.bc, bf_); LAS float* d_ = Ls + (bt * 2 + bwhich) * 128 + bseg * 8; *(LAS f32x4*)d_ = (f32x4){bf_[0], bf_[1], bf_[2], bf_[3]}; *(LAS f32x4*)(d_ + 4) = (f32x4){bf_[4], bf_[5], bf_[6], bf_[7]}; }
                if (task + 2 * G < 4096) SS_LOAD(task + 2 * G, R);
                lds_barrier();
#pragma unroll
                for (int t = 0; t < 8; ++t) {
                    const float dec = __expf(las[t]), xd = xs[t] * dts[t]; float y = 0.f;
#pragma unroll
                    for (int i = 0; i < 4; ++i) { const f32x4 Bv = *(const LAS f32x4*)(Ls + (t * 2) * 128 + ng * 4 + i * 32), Cv = *(const LAS f32x4*)(Ls + (t * 2 + 1) * 128 + ng * 4 + i * 32);
                        S[i] = S[i] * dec + Bv * xd; y += S[i][0] * Cv[0] + S[i][1] * Cv[1] + S[i][2] * Cv[2] + S[i][3] * Cv[3]; }
                    y = red8(y) + dsk * xs[t];
                    if (ng == 0) Q[(size_t)(r0 + t) * 3072 + hd * 64 + pr] = f2bf1(y);
                }
                float* so = p->out + O_SSD_STATE_S + ((((size_t)j * 128 + b) * 32 + hd) * 64 + pr) * 128 + ng * 4;
#pragma unroll
                for (int i = 0; i < 4; ++i) *(f32x4*)(so + i * 32) = S[i];
                lds_barrier();
            }
        }
    }
#undef SS_LOAD
}

__device__ __forceinline__ void gdn_out_phase(PP p, const int tidx, int j) {
    const int lane = tidx & 63, gw = blockIdx.x * 8 + (tidx >> 6), nw = gridDim.x * 8, hh = lane >> 4, eg = lane & 15;
    const bf16_t* F = (const bf16_t*)(p->ws + WS_F); const bf16_t* P = (const bf16_t*)(p->ws + WS_P); bf16_t* H = (bf16_t*)(p->ws + WS_H);
    const float* nwp = p->in[13] + j * 128 + eg * 8;
    const f32x4 n0 = *(const f32x4*)nwp, n1 = *(const f32x4*)(nwp + 4);
    for (int row0 = gw; row0 < T; row0 += 2 * nw) {
        u32x4 orr[2][2]; u32x4 gr[2][2];
#pragma unroll
        for (int r = 0; r < 2; ++r) { const int row = row0 + r * nw;
            if (row < T) {
#pragma unroll
                for (int pass = 0; pass < 2; ++pass) { const int c = pass * 512 + hh * 128 + eg * 8;
                    orr[r][pass] = *(const u32x4*)(F + (size_t)row * 1024 + c); gr[r][pass] = *(const u32x4*)(P + (size_t)row * NGDN + 3072 + c); } } }
#pragma unroll
        for (int r = 0; r < 2; ++r) { const int row = row0 + r * nw;
            if (row < T) {
#pragma unroll
                for (int pass = 0; pass < 2; ++pass) { const int c = pass * 512 + hh * 128 + eg * 8;
                    float of_[8]; unpack8(orr[r][pass], of_); const f32x4 a0 = (f32x4){of_[0], of_[1], of_[2], of_[3]}, a1 = (f32x4){of_[4], of_[5], of_[6], of_[7]};
                    float gt[8]; unpack8(gr[r][pass], gt);
                    float ss = a0[0] * a0[0] + a0[1] * a0[1] + a0[2] * a0[2] + a0[3] * a0[3] + a1[0] * a1[0] + a1[1] * a1[1] + a1[2] * a1[2] + a1[3] * a1[3];
                    ss = red16(ss); const float rr = rsqrtf(ss * (1.0f / 128) + EPS);
                    float v[8];
#pragma unroll
                    for (int i = 0; i < 4; ++i) { v[i] = a0[i] * rr * n0[i] * siluf(gt[i]); v[4 + i] = a1[i] * rr * n1[i] * siluf(gt[4 + i]); }
                    u32x4 w; w.x = cvt_pk_bf16(v[0], v[1]); w.y = cvt_pk_bf16(v[2], v[3]); w.z = cvt_pk_bf16(v[4], v[5]); w.w = cvt_pk_bf16(v[6], v[7]);
                    *(u32x4*)(H + (size_t)row * 1024 + c) = w; } } }
    }
}

__device__ __forceinline__ void ssd_out_phase(PP p, const int tidx, int j) {
    const int lane = tidx & 63, gw = blockIdx.x * 8 + (tidx >> 6), nw = gridDim.x * 8;
    const bf16_t* Q = (const bf16_t*)(p->ws + WS_Q); bf16_t* P = (bf16_t*)(p->ws + WS_P);
    const float* nwp = p->in[28] + (size_t)j * 2048;
    for (int row0 = gw; row0 < T; row0 += 2 * nw) {
        u32x4 yr[2][4]; u32x4 zr[2][4];
#pragma unroll
        for (int r = 0; r < 2; ++r) { const int row = row0 + r * nw;
            if (row < T) {
#pragma unroll
                for (int g = 0; g < 4; ++g) { const int c = g * 512 + lane * 8;
                    yr[r][g] = *(const u32x4*)(Q + (size_t)row * 3072 + c); zr[r][g] = *(const u32x4*)(P + (size_t)row * NSSD + c); } } }
#pragma unroll
        for (int r = 0; r < 2; ++r) { const int row = row0 + r * nw;
            if (row < T) {
#pragma unroll
                for (int g = 0; g < 4; ++g) { const int c = g * 512 + lane * 8;
                    float z[8]; unpack8(zr[r][g], z); float yv[8]; unpack8(yr[r][g], yv);
                    float v[8]; float ss = 0.f;
#pragma unroll
                    for (int i = 0; i < 4; ++i) { v[i] = yv[i] * siluf(z[i]); v[4 + i] = yv[4 + i] * siluf(z[4 + i]); }
#pragma unroll
                    for (int i = 0; i < 8; ++i) ss += v[i] * v[i];
                    ss = red64(ss); const float rr = rsqrtf(ss * (1.0f / 512) + EPS);
                    const f32x4 w0 = *(const f32x4*)(nwp + c), w1 = *(const f32x4*)(nwp + c + 4);
#pragma unroll
                    for (int i = 0; i < 4; ++i) { v[i] *= rr * w0[i]; v[4 + i] *= rr * w1[i]; }
                    u32x4 w; w.x = cvt_pk_bf16(v[0], v[1]); w.y = cvt_pk_bf16(v[2], v[3]); w.z = cvt_pk_bf16(v[4], v[5]); w.w = cvt_pk_bf16(v[6], v[7]);
                    *(u32x4*)(P + (size_t)row * NSSD + c) = w; } } }
    }
}

__device__ __forceinline__ void cm_ln_phase(PP p, const int tidx) {
    const int lane = tidx & 63, gw = blockIdx.x * 8 + (tidx >> 6), nw = gridDim.x * 8;
    bf16_t* P = (bf16_t*)(p->ws + WS_P);
    for (int row0 = gw; row0 < T; row0 += 2 * nw) {
        u32x4 raw[2][4];
#pragma unroll
        for (int r = 0; r < 2; ++r) { const int row = row0 + r * nw;
            if (row < T) {
#pragma unroll
                for (int i = 0; i < 4; ++i) raw[r][i] = *(const u32x4*)(P + (size_t)row * NCM + 2048 + i * 512 + lane * 8); } }
#pragma unroll
        for (int r = 0; r < 2; ++r) { const int row = row0 + r * nw;
            if (row < T) {
                float v[32];
#pragma unroll
                for (int i = 0; i < 4; ++i) unpack8(raw[r][i], v + i * 8);
                float sm = 0.f;
#pragma unroll
                for (int i = 0; i < 32; ++i) sm += v[i];
                sm = red64(sm); const float mu = sm * (1.0f / 2048);
                float q = 0.f;
#pragma unroll
                for (int i = 0; i < 32; ++i) { v[i] -= mu; q += v[i] * v[i]; }
                q = red64(q); const float rr = rsqrtf(q * (1.0f / 2048) + EPS);
#pragma unroll
                for (int i = 0; i < 4; ++i) { const int c = i * 512 + lane * 8;
                    const f32x4 w0 = *(const f32x4*)(p->in[17] + c), w1 = *(const f32x4*)(p->in[17] + c + 4), b0 = *(const f32x4*)(p->in[18] + c), b1 = *(const f32x4*)(p->in[18] + c + 4);
                    float o[8];
#pragma unroll
                    for (int e = 0; e < 4; ++e) { o[e] = v[i * 8 + e] * rr * w0[e] + b0[e]; o[4 + e] = v[i * 8 + 4 + e] * rr * w1[e] + b1[e]; }
                    u32x4 w; w.x = cvt_pk_bf16(o[0], o[1]); w.y = cvt_pk_bf16(o[2], o[3]); w.z = cvt_pk_bf16(o[4], o[5]); w.w = cvt_pk_bf16(o[6], o[7]);
                    *(u32x4*)(P + (size_t)row * NCM + 2048 + c) = w;
                    if (row >= TP) { float* oo = p->out + O_CMLP_V_S + (size_t)(row - TP) * 2048 + c; *(f32x4*)oo = (f32x4){o[0], o[1], o[2], o[3]}; *(f32x4*)(oo + 4) = (f32x4){o[4], o[5], o[6], o[7]}; }
                } } }
    }
}

__device__ __forceinline__ void cm_mix_phase(PP p, const int tidx) {
    const int tid = tidx, wave = tid >> 6, lane = tid & 63, fr = lane & 15, fq = lane >> 4;
    const bf16_t* P = (const bf16_t*)(p->ws + WS_P); const bf16_t* WSB = (const bf16_t*)(p->ws + WS_WSB); bf16_t* MO = (bf16_t*)(p->ws + WS_Q);
    const float* bs = p->in[20];
    for (int unit = blockIdx.x; unit < 1024; unit += gridDim.x) {
        const int hg = unit & 7, z = (unit >> 3) & 15, b = unit >> 7;
        const int rbase = b * SEQ + z * 128, d0 = hg * 256 + wave * 32;
        f32x4 acc[2][8];
#pragma unroll
        for (int a = 0; a < 2; ++a)
#pragma unroll
            for (int c = 0; c < 8; ++c) acc[a][c] = (f32x4){0.f, 0.f, 0.f, 0.f};
#pragma unroll
        for (int ks = 0; ks < 4; ++ks) {
            bf16x8 av[2];
#pragma unroll
            for (int dn = 0; dn < 2; ++dn)
#pragma unroll
                for (int i = 0; i < 8; ++i) av[dn][i] = (short)P[(size_t)(rbase + ks * 32 + fq * 8 + i) * NCM + 2048 + d0 + dn * 16 + fr];
#pragma unroll
            for (int tn = 0; tn < 8; ++tn) {
                if (ks * 32 <= tn * 16 + 15) {
                    const bf16x8 bv = *(const bf16x8*)(WSB + ((size_t)hg * 128 + tn * 16 + fr) * 128 + ks * 32 + fq * 8);
                    acc[0][tn] = __builtin_amdgcn_mfma_f32_16x16x32_bf16(av[0], bv, acc[0][tn], 0, 0, 0);
                    acc[1][tn] = __builtin_amdgcn_mfma_f32_16x16x32_bf16(av[1], bv, acc[1][tn], 0, 0, 0);
                }
            }
        }
#pragma unroll
        for (int tn = 0; tn < 8; ++tn) {
            const int t = tn * 16 + fr; const float bias = bs[hg * 128 + t]; const size_t row = (size_t)(rbase + t);
#pragma unroll
            for (int dn = 0; dn < 2; ++dn) {
                const int d = d0 + dn * 16 + fq * 4;
                const u32x2 uu = *(const u32x2*)(P + row * NCM + d);
                const float o0 = bf_lo(uu.x) * (acc[dn][tn][0] + bias), o1 = bf_hi(uu.x) * (acc[dn][tn][1] + bias), o2 = bf_lo(uu.y) * (acc[dn][tn][2] + bias), o3 = bf_hi(uu.y) * (acc[dn][tn][3] + bias);
                u32x2 w; w.x = cvt_pk_bf16(o0, o1); w.y = cvt_pk_bf16(o2, o3);
                *(u32x2*)(MO + row * 2048 + d) = w;
            }
        }
    }
    const float* wsf = p->in[19];
    for (int unit = blockIdx.x * 8 + wave; unit < 1024; unit += gridDim.x * 8) {
        const int hg = unit & 7, b = unit >> 3; const int r0 = TP + b * 8, d = hg * 256 + lane * 4;
        float vn[8][4];
#pragma unroll
        for (int s = 0; s < 8; ++s) { const u32x2 w = *(const u32x2*)(P + (size_t)(r0 + s) * NCM + 2048 + d); vn[s][0] = bf_lo(w.x); vn[s][1] = bf_hi(w.x); vn[s][2] = bf_lo(w.y); vn[s][3] = bf_hi(w.y); }
#pragma unroll
        for (int t = 0; t < 8; ++t) {
            const float bias = bs[hg * 128 + t]; float m[4] = {bias, bias, bias, bias};
#pragma unroll
            for (int s = 0; s <= t; ++s) { const float w = wsf[((size_t)hg * 128 + t) * 128 + s];
#pragma unroll
                for (int e = 0; e < 4; ++e) m[e] += w * vn[s][e]; }
            const u32x2 uu = *(const u32x2*)(P + (size_t)(r0 + t) * NCM + d);
            u32x2 w; w.x = cvt_pk_bf16(bf_lo(uu.x) * m[0], bf_hi(uu.x) * m[1]); w.y = cvt_pk_bf16(bf_lo(uu.y) * m[2], bf_hi(uu.y) * m[3]);
            *(u32x2*)(MO + (size_t)(r0 + t) * 2048 + d) = w;
        }
    }
}

#define XB_TMO      128
#define XB_XCNT(j)  (256  + 64 * (j))
#define XB_XSUB(j)  (1280 + 64 * (j))
#define XB_XGEN(j)  (2304 + 64 * (j))
#define XB_TOP      3328
#define XB_TOPGEN   3392
#define XCD_BAR_WORDS 3456
#define XB_SPIN_CAP (1u << 22)
__device__ __forceinline__ unsigned xb_ld(unsigned* p)              { return __hip_atomic_load(p, __ATOMIC_RELAXED, __HIP_MEMORY_SCOPE_AGENT); }
__device__ __forceinline__ unsigned xb_add(unsigned* p, unsigned v) { return __hip_atomic_fetch_add(p, v, __ATOMIC_RELAXED, __HIP_MEMORY_SCOPE_AGENT); }
__device__ __forceinline__ unsigned xb_xcc_id() { return (unsigned)__builtin_amdgcn_s_getreg((3 << 11) | 20) & 0xFu; }
#define XB_SPIN(cond, bar) do { unsigned _sp = 0; while (cond) { __builtin_amdgcn_s_sleep(1); \
    if ((++_sp & 255u) == 0u) { if (xb_ld(&(bar)[XB_TMO])) break; if (_sp > XB_SPIN_CAP) { atomicAdd(&(bar)[XB_TMO], 1u); break; } } } } while (0)
struct XcdBarrier { unsigned* bar; unsigned x; volatile LAS unsigned* st; };
__device__ __forceinline__ XcdBarrier xcd_barrier_post(unsigned* bar, volatile LAS unsigned* st) {
    XcdBarrier b; b.bar = bar; b.x = xb_xcc_id(); b.st = st;
    if (threadIdx.x == 0) (void)xb_add(&bar[XB_XCNT(b.x)], 1u);
    return b;
}
__device__ __forceinline__ void xcd_barrier_complete(unsigned* bar, unsigned x, unsigned& nloc, unsigned& nx) {
    const unsigned G = gridDim.x * gridDim.y * gridDim.z;
    unsigned sum, cnt, mine, sp = 0u;
    for (;;) {
        sum = 0u; cnt = 0u; mine = 0u;
#pragma unroll
        for (unsigned j = 0; j < 16; ++j) { const unsigned c = xb_ld(&bar[XB_XCNT(j)]); sum += c; cnt += (c > 0u) ? 1u : 0u; mine = (j == x) ? c : mine; }
        if (sum == G) break;
        __builtin_amdgcn_s_sleep(1);
        if ((++sp & 255u) == 0u) { if (xb_ld(&bar[XB_TMO])) break; if (sp > XB_SPIN_CAP) { atomicAdd(&bar[XB_TMO], 1u); break; } }
    }
    nloc = mine > 0u ? mine : 1u; nx = cnt > 0u ? cnt : 1u;
}
__device__ __forceinline__ void xcd_barrier(const XcdBarrier& b) {
    asm volatile("s_waitcnt vmcnt(0)" ::: "memory");
    __syncthreads();
    if (threadIdx.x == 0) {
        unsigned* bar = b.bar;
        __builtin_amdgcn_s_waitcnt(0);
        unsigned nloc = b.st[0], nx = b.st[1];
        if (nloc == 0u) { xcd_barrier_complete(bar, b.x, nloc, nx); b.st[0] = nloc; b.st[1] = nx; }
        const unsigned old = xb_add(&bar[XB_XSUB(b.x)], 1u);
        const unsigned gen = old / nloc;
        if (old + 1u == (gen + 1u) * nloc) {
            __builtin_amdgcn_fence(__ATOMIC_RELEASE, "agent");
            asm volatile("s_waitcnt vmcnt(0)" ::: "memory");
            const unsigned og = xb_add(&bar[XB_TOP], 1u);
            const unsigned tg = og / nx;
            if (og + 1u == (tg + 1u) * nx) xb_add(&bar[XB_TOPGEN], 1u);
            else XB_SPIN(xb_ld(&bar[XB_TOPGEN]) == tg, bar);
            __builtin_amdgcn_fence(__ATOMIC_ACQUIRE, "agent");
            xb_add(&bar[XB_XGEN(b.x)], 1u);
            asm volatile("s_waitcnt vmcnt(0)" ::: "memory");
        } else {
            XB_SPIN(xb_ld(&bar[XB_XGEN(b.x)]) == gen, bar);
            __builtin_amdgcn_fence(__ATOMIC_ACQUIRE, "agent");
            asm volatile("s_waitcnt vmcnt(0)" ::: "memory");
        }
    }
    __syncthreads();
}

template <bool COOP>
__global__ void __launch_bounds__(512, 2) mk_fwd(Params p_unused) {
    extern __shared__ __attribute__((aligned(16))) unsigned char lds_raw[];
    LAS unsigned char* lds = (LAS unsigned char*)lds_raw;
    PP p0 = (PP)__builtin_amdgcn_kernarg_segment_ptr();
    const int lo = p0->lo, hi = p0->hi;
    XcdBarrier xbar; xbar.bar = nullptr; xbar.x = 0; xbar.st = nullptr;
    if (COOP) { volatile LAS unsigned* st = (volatile LAS unsigned*)(lds + 131072); if (threadIdx.x < 4) st[threadIdx.x] = 0u; __syncthreads();
        xbar = xcd_barrier_post((unsigned*)(p0->ws + WS_BAR), st); }
    for (int ph = lo; ph < hi; ++ph) {
        PP p = p0; asm volatile("" : "+s"(p));
        int tidx = threadIdx.x; asm volatile("" : "+v"(tidx));
        unsigned char* ws = p->ws;
        const int code = p->prog[ph], op = code & 15, layer = (code >> 4) & 3, part = code >> 6;
        const int kind = layer % 3, j = layer / 3;
        if (op == OP_PROLOGUE) {
            LAS float* tile = (LAS float*)lds;
            for (int m = 0; m < 8; ++m) conv_job(tidx, tile, p->in[7] + (size_t)m * 1024 * 5632, 1024, 5632, (bf16_t*)(ws + WS_FFN_IN) + (size_t)m * 5632 * 1024, 5632, 1);
            for (int m = 0; m < 8; ++m) conv_job(tidx, tile, p->in[8] + (size_t)m * 2816 * 1024, 2816, 1024, (bf16_t*)(ws + WS_FFN_OUT) + (size_t)m * 1024 * 2816, 1024, 0);
            for (int m = 0; m < 2; ++m) conv_job(tidx, tile, p->in[9] + (size_t)m * 1024 * 4112, 1024, 4112, (bf16_t*)(ws + WS_GDN_IN) + (size_t)m * NGDN * 1024, NGDN, 0);
            for (int m = 0; m < 2; ++m) conv_job(tidx, tile, p->in[14] + (size_t)m * 1024 * 1024, 1024, 1024, (bf16_t*)(ws + WS_GDN_OUT) + (size_t)m * 1024 * 1024, 1024, 0);
            conv_job(tidx, tile, p->in[15], 1024, 4096, (bf16_t*)(ws + WS_CM_IN), NCM, 0);
            conv_job(tidx, tile, p->in[21], 2048, 1024, (bf16_t*)(ws + WS_CM_OUT), 1024, 0);
            conv_job(tidx, tile, p->in[22], 1024, 5152, (bf16_t*)(ws + WS_SSD_IN), NSSD, 0);
            conv_job(tidx, tile, p->in[29], 2048, 1024, (bf16_t*)(ws + WS_SSD_OUT), 1024, 0);
            { bf16_t* wsb = (bf16_t*)(ws + WS_WSB); const float* w = p->in[19];
              for (int i = blockIdx.x * 512 + tidx; i < 8 * 128 * 128; i += gridDim.x * 512) { const int s = i & 127, t = (i >> 7) & 127; wsb[i] = (bf16_t)(cvt_pk_bf16(s <= t ? w[i] : 0.f, 0.f) & 0xffffu); } }
#if MK_DBG != 1
            row_phase(p, tidx, nullptr, 0.f, nullptr, p->in[6], true, 0);
#endif
        } else if (op == OP_GEMM_SWIGLU) {
            pg8::Gemm g{(const bf16_t*)(ws + WS_H), (const bf16_t*)(ws + WS_FFN_IN) + (size_t)(layer * 2 + (part >> 1)) * 5632 * 1024, T, 5632, 1024, 1024, 1024};
            pg8::StaticOrder S; S.init(T, 5632, gridDim.x, blockIdx.x);
            pg8::EpiSwiGLU E{(bf16_t*)(ws + WS_Q), DFF};
            pg8::gemm_phase(tidx, lds, g, S, E);
        } else if (op == OP_GEMM_F32) {
            const bf16_t* A; const bf16_t* Bt; int K, lda;
            if (part != 1) { A = (const bf16_t*)(ws + WS_Q); Bt = (const bf16_t*)(ws + WS_FFN_OUT) + (size_t)(layer * 2 + (part >> 1)) * 1024 * 2816; K = DFF; lda = DFF; }
            else if (kind == 0) { A = (const bf16_t*)(ws + WS_H); Bt = (const bf16_t*)(ws + WS_GDN_OUT) + (size_t)j * 1024 * 1024; K = 1024; lda = 1024; }
            else if (kind == 1) { A = (const bf16_t*)(ws + WS_Q); Bt = (const bf16_t*)(ws + WS_CM_OUT); K = 2048; lda = 2048; }
            else { A = (const bf16_t*)(ws + WS_P); Bt = (const bf16_t*)(ws + WS_SSD_OUT); K = 2048; lda = NSSD; }
            {
                pg8::Gemm g{A, Bt, TP, 1024, K, lda, K};
                pg8::StaticOrder S; S.init(TP, 1024, gridDim.x, blockIdx.x);
                pg8::EpiBf16<0> E{(bf16_t*)(ws + WS_F), 1024, nullptr};
                pg8::gemm_phase(tidx, lds, g, S, E);
            }
            {
                pg8::Gemm g{A + (size_t)TP * lda, Bt, TS, 1024, 256, lda, K};
                pg8::SplitOrder S; S.init(K / 256, gridDim.x, blockIdx.x);
                pg8::EpiBf16Part E{(bf16_t*)(ws + WS_PART)};
                pg8::gemm_phase(tidx, lds, g, S, E);
            }
        } else if (op == OP_ROW) {
            const float* nw = p->in[6] + (size_t)layer * 6 * D;
            const float coef = part == 1 ? 1.0f : 0.5f;
            const float* wpost = nw + (part * 2 + 1) * D;
            const float* wpre = part < 2 ? nw + (part * 2 + 2) * D : (layer < 3 ? nw + 6 * D : nullptr);
            row_phase(p, tidx, (const float*)(ws + WS_F), coef, wpost, wpre, layer == 0 && part == 0, part != 1 ? 11 : (kind == 0 ? 4 : 8));
        } else if (op == OP_GEMM_IN) {
            const int N = kind == 0 ? NGDN : NSSD;
            pg8::Gemm g{(const bf16_t*)(ws + WS_H), kind == 0 ? (const bf16_t*)(ws + WS_GDN_IN) + (size_t)j * NGDN * 1024 : (const bf16_t*)(ws + WS_SSD_IN), T, N, 1024, 1024, 1024};
            pg8::StaticOrder S; S.init(T, N, gridDim.x, blockIdx.x);
            pg8::EpiBf16<0> E{(bf16_t*)(ws + WS_P), N, nullptr};
            pg8::gemm_phase(tidx, lds, g, S, E);
        } else if (op == OP_GEMM_IN_GELU) {
            pg8::Gemm g{(const bf16_t*)(ws + WS_H), (const bf16_t*)(ws + WS_CM_IN), T, NCM, 1024, 1024, 1024};
            pg8::StaticOrder S; S.init(T, NCM, gridDim.x, blockIdx.x);
            pg8::EpiBf16<1> E{(bf16_t*)(ws + WS_P), NCM, p->in[16]};
            pg8::gemm_phase(tidx, lds, g, S, E);
        } else if (op == OP_GDN_PREP) { prep_phase<0>(p, tidx, j);
        } else if (op == OP_GDN_R1) { gdn_r1(p, tidx, lds, j); gdn_sample(p, tidx, (LAS float*)lds, j);
        } else if (op == OP_GDN_REC) { gdn_r2(p, tidx, lds, j);
        } else if (op == OP_GDN_OUT) { gdn_out_phase(p, tidx, j);
        } else if (op == OP_CM_LN) { cm_ln_phase(p, tidx);
        } else if (op == OP_CM_MIX) { cm_mix_phase(p, tidx);
        } else if (op == OP_SSD_PREP) { prep_phase<1>(p, tidx, j);
        } else if (op == OP_SSD_REC) { ssd_chunked(p, tidx, lds, j); ssd_sample(p, tidx, (LAS float*)lds, j);
        } else if (op == OP_SSD_OUT) { ssd_out_phase(p, tidx, j); }
        if (COOP) { if (ph + 1 < hi) {
#if MK_CGSYNC
            cg::this_grid().sync();
#else
            xcd_barrier(xbar);
#endif
        } }
    }
}

static int build_prog(unsigned char* prog) {
    int n = 0;
    prog[n++] = OP_PROLOGUE;
    for (int layer = 0; layer < 4; ++layer) {
        const int kind = layer % 3;
        auto emit = [&](int op, int part) { prog[n++] = (unsigned char)(op | (layer << 4) | (part << 6)); };
        emit(OP_GEMM_SWIGLU, 0); emit(OP_GEMM_F32, 0); emit(OP_ROW, 0);
        if (kind == 0) { emit(OP_GEMM_IN, 1); emit(OP_GDN_PREP, 1); emit(OP_GDN_R1, 1); emit(OP_GDN_REC, 1); emit(OP_GDN_OUT, 1); }
        else if (kind == 1) { emit(OP_GEMM_IN_GELU, 1); emit(OP_CM_LN, 1); emit(OP_CM_MIX, 1); }
        else { emit(OP_GEMM_IN, 1); emit(OP_SSD_PREP, 1); emit(OP_SSD_REC, 1); emit(OP_SSD_OUT, 1); }
        emit(OP_GEMM_F32, 1); emit(OP_ROW, 1);
        emit(OP_GEMM_SWIGLU, 2); emit(OP_GEMM_F32, 2); emit(OP_ROW, 2);
    }
    return n;
}

extern "C" void kernel_launch(void* const* d_in, const int* in_sizes, int n_in, void* d_out, int out_size, void* d_ws, size_t ws_size, hipStream_t stream) {
    static int grid = 0;
    if (grid == 0) {
        if (n_in != 30 || (size_t)out_size != O_END || ws_size < WS_END) { fprintf(stderr, "kernel_launch: unexpected shapes n_in %d out %d ws %zu (need %zu)\n", n_in, out_size, ws_size, (size_t)WS_END); grid = -1; return; }
        int dev = 0, cus = 0, per_cu = 0;
        hipGetDevice(&dev); hipDeviceGetAttribute(&cus, hipDeviceAttributeMultiprocessorCount, dev);
        hipFuncSetAttribute((const void*)mk_fwd<true>, hipFuncAttributeMaxDynamicSharedMemorySize, LDS_BYTES);
        hipFuncSetAttribute((const void*)mk_fwd<false>, hipFuncAttributeMaxDynamicSharedMemorySize, LDS_BYTES);
        hipOccupancyMaxActiveBlocksPerMultiprocessor(&per_cu, (const void*)mk_fwd<true>, 512, LDS_BYTES);
        per_cu = 1;
        grid = cus * per_cu;
        (void)hipGetLastError();
    }
    if (grid < 0) return;
    Params p{};
    for (int i = 0; i < 30; ++i) p.in[i] = (const float*)d_in[i];
    p.out = (float*)d_out; p.ws = (unsigned char*)d_ws;
    int nph = build_prog(p.prog);
#ifdef MK_NPH
    if (nph > MK_NPH) nph = MK_NPH;
#endif
#if MK_COOP
    p.lo = 0; p.hi = nph;
    hipMemsetAsync((unsigned char*)d_ws + WS_BAR, 0, 16384, stream);
    void* args[] = {&p};
    hipError_t e = hipLaunchCooperativeKernel((const void*)mk_fwd<true>, dim3(grid), dim3(512), args, LDS_BYTES, stream);
    if (e != hipSuccess) fprintf(stderr, "cooperative launch failed: %s (grid %d)\n", hipGetErrorString(e), grid);
#else
    for (int ph = 0; ph < nph; ++ph) { p.lo = ph; p.hi = ph + 1 - MK_EMPTY; hipLaunchKernelGGL(mk_fwd<false>, dim3(grid), dim3(512), LDS_BYTES, stream, p); }
#endif
}
```

```cpp
#include <hip/hip_runtime.h>
#include <hip/hip_cooperative_groups.h>
#include <cstdio>
namespace cg = cooperative_groups;

#ifndef MK_COOP
#define MK_COOP 1
#endif

#define MK_EMPTY 0
#ifndef MK_CGSYNC
#define MK_CGSYNC 0
#endif
#define MK_DBG 0
#define LAS __attribute__((address_space(3)))
typedef unsigned short bf16_t;
typedef short bf16x8 __attribute__((ext_vector_type(8)));
typedef float f32x4 __attribute__((ext_vector_type(4)));
typedef float f32x2 __attribute__((ext_vector_type(2)));
typedef unsigned u32x4 __attribute__((ext_vector_type(4)));
typedef unsigned u32x2 __attribute__((ext_vector_type(2)));

constexpr int TP = 16384, TS = 1024, T = TP + TS, D = 1024, DFF = 2816, SEQ = 2048;
constexpr int NGDN = 4352, NCM = 4096, NSSD = 5376;
constexpr float EPS = 1e-6f;
constexpr size_t O_X = 0;
constexpr size_t O_GDN_STATE_P = (size_t)T * D;
constexpr size_t O_GDN_CONV_P = O_GDN_STATE_P + (size_t)2 * 8 * 8 * 128 * 128;
constexpr size_t O_SSD_STATE_P = O_GDN_CONV_P + (size_t)2 * 8 * 3 * 3072;
constexpr size_t O_SSD_CONV_P = O_SSD_STATE_P + (size_t)8 * 32 * 64 * 128;
constexpr size_t O_GDN_STATE_S = O_SSD_CONV_P + (size_t)8 * 3 * 3072;
constexpr size_t O_GDN_CONV_S = O_GDN_STATE_S + (size_t)2 * 128 * 8 * 128 * 128;
constexpr size_t O_SSD_STATE_S = O_GDN_CONV_S + (size_t)2 * 128 * 3 * 3072;
constexpr size_t O_SSD_CONV_S = O_SSD_STATE_S + (size_t)128 * 32 * 64 * 128;
constexpr size_t O_CMLP_V_S = O_SSD_CONV_S + (size_t)128 * 3 * 3072;
constexpr size_t O_END = O_CMLP_V_S + (size_t)128 * 8 * 2048;
constexpr size_t WS_FFN_IN = 0;
constexpr size_t WS_FFN_OUT = WS_FFN_IN + (size_t)8 * 5632 * 1024 * 2;
constexpr size_t WS_GDN_IN = WS_FFN_OUT + (size_t)8 * 1024 * 2816 * 2;
constexpr size_t WS_GDN_OUT = WS_GDN_IN + (size_t)2 * NGDN * 1024 * 2;
constexpr size_t WS_CM_IN = WS_GDN_OUT + (size_t)2 * 1024 * 1024 * 2;
constexpr size_t WS_CM_OUT = WS_CM_IN + (size_t)NCM * 1024 * 2;
constexpr size_t WS_SSD_IN = WS_CM_OUT + (size_t)1024 * 2048 * 2;
constexpr size_t WS_SSD_OUT = WS_SSD_IN + (size_t)NSSD * 1024 * 2;
constexpr size_t WS_WSB = WS_SSD_OUT + (size_t)1024 * 2048 * 2;
constexpr size_t WS_H = WS_WSB + (size_t)8 * 128 * 128 * 2;
constexpr size_t WS_F = WS_H + (size_t)T * 1024 * 2;
constexpr size_t WS_P = WS_F + (size_t)T * 1024 * 4;
constexpr size_t WS_Q = WS_P + (size_t)T * NSSD * 2;
constexpr size_t WS_PART = WS_Q + (size_t)T * 2816 * 2;
constexpr size_t WS_AB = WS_Q + (size_t)T * 3072 * 4;
constexpr size_t WS_BAR = WS_AB + (size_t)T * 64 * 4;
constexpr size_t WS_G = WS_BAR + 16384;
constexpr size_t WS_END = WS_G + (size_t)64 * 2048 * 4;

constexpr int LDS_BYTES = 131072 + 16;

enum { OP_PROLOGUE = 0, OP_GEMM_SWIGLU, OP_GEMM_F32, OP_ROW, OP_GEMM_IN, OP_GEMM_IN_GELU, OP_GDN_PREP, OP_GDN_REC, OP_GDN_OUT,
       OP_CM_LN, OP_CM_MIX, OP_SSD_PREP, OP_SSD_REC, OP_SSD_OUT, OP_GDN_R1 };

struct Params {
    const float* in[30];
    float* out;
    unsigned char* ws;
    int lo, hi;
    unsigned char prog[64];
};
typedef const __attribute__((address_space(4))) Params* PP;

typedef __bf16 bf16v2 __attribute__((ext_vector_type(2)));
__device__ __forceinline__ unsigned cvt_pk_bf16(float lo, float hi) { f32x2 v = {lo, hi}; bf16v2 b = __builtin_convertvector(v, bf16v2); return __builtin_bit_cast(unsigned, b); }
__device__ __forceinline__ float bf_lo(unsigned w) { return __uint_as_float(w << 16); }
__device__ __forceinline__ float bf_hi(unsigned w) { return __uint_as_float(w & 0xffff0000u); }
__device__ __forceinline__ void unpack8(u32x4 w, float* f) { f[0] = bf_lo(w.x); f[1] = bf_hi(w.x); f[2] = bf_lo(w.y); f[3] = bf_hi(w.y); f[4] = bf_lo(w.z); f[5] = bf_hi(w.z); f[6] = bf_lo(w.w); f[7] = bf_hi(w.w); }
__device__ __forceinline__ float siluf(float x) { return x * __builtin_amdgcn_rcpf(1.0f + __expf(-x)); }
__device__ __forceinline__ float sigmoidf_(float x) { return __builtin_amdgcn_rcpf(1.0f + __expf(-x)); }
__device__ __forceinline__ float softplusf_(float x) { return x > 20.f ? x : log1pf(__expf(x)); }
template <int CTRL> __device__ __forceinline__ float dppf(float x) { return __int_as_float(__builtin_amdgcn_update_dpp(0, __float_as_int(x), CTRL, 0xF, 0xF, true)); }
__device__ __forceinline__ float red4(float x) { x += dppf<0xB1>(x); x += dppf<0x4E>(x); return x; }
__device__ __forceinline__ float red8(float x) { x = red4(x); x += dppf<0x141>(x); return x; }
__device__ __forceinline__ float red16(float x) { x = red8(x); x += dppf<0x140>(x); return x; }
__device__ __forceinline__ float red64(float x) { x = red16(x); x += __shfl_xor(x, 16); x += __shfl_xor(x, 32); return x; }

__device__ __forceinline__ void lds_barrier() { asm volatile("s_waitcnt lgkmcnt(0)" ::: "memory"); __builtin_amdgcn_s_barrier(); asm volatile("" ::: "memory"); }

namespace pg8 {
constexpr int BM = 256, BK = 64, HALF = 128, HTB = HALF * BK * 2, STAGE_BYTES = 8 * HTB, NXCD = 8, WGM = 4;
__device__ __forceinline__ int lds_byte(int r, int c) { const int st = (r >> 4) * 2 + (c >> 5), rr = r & 15, cc = c & 31, ob = rr * 64 + cc * 2; return st * 1024 + (ob ^ (((ob >> 9) & 1) << 5)); }
__device__ __forceinline__ void stage_rc(int b, int& R, int& C) { const int st = b / 1024, sb = b % 1024, swz = sb ^ (((sb >> 9) & 1) << 5); R = (st >> 1) * 16 + swz / 64; C = (st & 1) * 32 + (swz % 64) / 2; }
__device__ __forceinline__ int perm32(int rho) { const int n = rho >> 4, i = rho & 15; return 8 * (i >> 2) + 4 * n + (i & 3); }
struct Unit { int pm, pn, kz; };
struct Gemm { const bf16_t* A; const bf16_t* Bt; int M, N, K, lda, ldb; };
struct StaticOrder {
    int nM, nN, nwg, G, c;
    __device__ void init(int M, int N, int G_, int c_) { nM = M / BM; nN = N / BM; nwg = nM * nN; G = G_; c = c_; }
    __device__ bool next(int i, Unit& u) const {
        const long L = (long)i * G + c; if (L >= nwg) return false;
        int wgid = (int)L; { const int q = nwg / NXCD, r = nwg % NXCD, xcd = wgid % NXCD, off = wgid / NXCD; wgid = (xcd < r ? xcd * (q + 1) : r * (q + 1) + (xcd - r) * q) + off; }
        const int nig = WGM * nN, gid = wgid / nig, fm = gid * WGM, gsz = (nM - fm) < WGM ? (nM - fm) : WGM;
        u.pm = fm + ((wgid % nig) % gsz); u.pn = (wgid % nig) / gsz; u.kz = 0; return true;
    }
};
struct SplitOrder {
    int items, G, c;
    __device__ void init(int S, int G_, int c_) { items = 16 * S; G = G_; c = c_; }
    __device__ bool next(int i, Unit& u) const { const int L = i * G + c; if (L >= items) return false; u.kz = L >> 4; u.pm = (L >> 2) & 3; u.pn = L & 3; return true; }
};
struct EpiF32 {
    static constexpr bool PERM = false;
    float* C; int ldc;
    __device__ __forceinline__ void operator()(const f32x4 (&acc)[2][2][4][2], const Unit& u, int wr, int wc, int fr, int fq) const {
        const int row0 = u.pm * BM + wr * 64 + fr, col0 = u.pn * BM + wc * 32 + 4 * fq;
#pragma unroll
        for (int ai = 0; ai < 2; ++ai)
#pragma unroll
            for (int m = 0; m < 4; ++m) { float* rowp = C + (size_t)(row0 + ai * HALF + m * 16) * ldc + col0;
#pragma unroll
                for (int bj = 0; bj < 2; ++bj)
#pragma unroll
                    for (int n = 0; n < 2; ++n) *(f32x4*)(rowp + bj * HALF + n * 16) = acc[ai][bj][m][n]; }
    }
};
struct EpiBf16Part {
    static constexpr bool PERM = true;
    bf16_t* part;
    __device__ __forceinline__ void operator()(const f32x4 (&acc)[2][2][4][2], const Unit& u, int wr, int wc, int fr, int fq) const {
        const int row0 = u.pm * BM + wr * 64 + fr; const int col0 = u.pn * BM + wc * 32 + 8 * fq;
        bf16_t* C = part + (size_t)u.kz * 1024 * 1024;
#pragma unroll
        for (int ai = 0; ai < 2; ++ai)
#pragma unroll
            for (int m = 0; m < 4; ++m) { bf16_t* rowp = C + (size_t)(row0 + ai * HALF + m * 16) * 1024 + col0;
#pragma unroll
                for (int bj = 0; bj < 2; ++bj) { const f32x4 v0 = acc[ai][bj][m][0], v1 = acc[ai][bj][m][1];
                    u32x4 w; w.x = cvt_pk_bf16(v0[0], v0[1]); w.y = cvt_pk_bf16(v0[2], v0[3]); w.z = cvt_pk_bf16(v1[0], v1[1]); w.w = cvt_pk_bf16(v1[2], v1[3]);
                    *(u32x4*)(rowp + bj * HALF) = w; } }
    }
};
__device__ __forceinline__ f32x2 gelu_pk(f32x2 v) {
    const f32x2 av = __builtin_elementwise_abs(v), d = av * 0.2316418882f + 1.0f;
    f32x2 t; t.x = __builtin_amdgcn_rcpf(d.x); t.y = __builtin_amdgcn_rcpf(d.y);
    f32x2 q = t * 0.5307027145f + (-0.7265760135f); q = q * t + 0.7107068705f; q = q * t + (-0.142248368f); q = q * t + 0.127414796f; q = q * t;
    const f32x2 s = (v * v) * (-0.72134752044f);
    f32x2 e; e.x = __builtin_amdgcn_exp2f(s.x); e.y = __builtin_amdgcn_exp2f(s.y);
    const f32x2 m = v * (q * e), r = v - m;
    f32x2 o; o.x = v.x < 0.f ? m.x : r.x; o.y = v.y < 0.f ? m.y : r.y; return o;
}
template <int ACT> struct EpiBf16 {
    static constexpr bool PERM = true;
    bf16_t* O; int ldc; const float* bias;
    __device__ __forceinline__ void operator()(const f32x4 (&acc)[2][2][4][2], const Unit& u, int wr, int wc, int fr, int fq) const {
        const int row0 = u.pm * BM + wr * 64 + fr; const int col0 = u.pn * BM + wc * 32 + 8 * fq;
        f32x4 bv[2][2];
#pragma unroll
        for (int bj = 0; bj < 2; ++bj)
#pragma unroll
            for (int n = 0; n < 2; ++n) bv[bj][n] = bias ? *(const f32x4*)(bias + col0 + bj * HALF + 4 * n) : (f32x4){0.f, 0.f, 0.f, 0.f};
#pragma unroll
        for (int ai = 0; ai < 2; ++ai)
#pragma unroll
            for (int m = 0; m < 4; ++m) { bf16_t* rowp = O + (size_t)(row0 + ai * HALF + m * 16) * ldc + col0;
#pragma unroll
                for (int bj = 0; bj < 2; ++bj) { f32x4 v0 = acc[ai][bj][m][0] + bv[bj][0], v1 = acc[ai][bj][m][1] + bv[bj][1];
                    if (ACT == 1) { f32x2 a = gelu_pk((f32x2){v0[0], v0[1]}), b = gelu_pk((f32x2){v0[2], v0[3]}), c = gelu_pk((f32x2){v1[0], v1[1]}), d = gelu_pk((f32x2){v1[2], v1[3]});
                        v0 = (f32x4){a.x, a.y, b.x, b.y}; v1 = (f32x4){c.x, c.y, d.x, d.y}; }
                    u32x4 w; w.x = cvt_pk_bf16(v0[0], v0[1]); w.y = cvt_pk_bf16(v0[2], v0[3]); w.z = cvt_pk_bf16(v1[0], v1[1]); w.w = cvt_pk_bf16(v1[2], v1[3]);
                    *(u32x4*)(rowp + bj * HALF) = w; } }
    }
};
struct EpiSwiGLU {
    static constexpr bool PERM = true;
    bf16_t* O; int ldc;
    __device__ __forceinline__ void operator()(const f32x4 (&acc)[2][2][4][2], const Unit& u, int wr, int wc, int fr, int fq) const {
        const int row0 = u.pm * BM + wr * 64 + fr; const int col0 = u.pn * HALF + wc * 32 + 8 * fq;
#pragma unroll
        for (int ai = 0; ai < 2; ++ai)
#pragma unroll
            for (int m = 0; m < 4; ++m) { bf16_t* rowp = O + (size_t)(row0 + ai * HALF + m * 16) * ldc + col0;
                float r[8];
#pragma unroll
                for (int n = 0; n < 2; ++n)
#pragma unroll
                    for (int j = 0; j < 4; ++j) { const float g = acc[ai][0][m][n][j], up = acc[ai][1][m][n][j]; r[n * 4 + j] = siluf(g) * up; }
                u32x4 w; w.x = cvt_pk_bf16(r[0], r[1]); w.y = cvt_pk_bf16(r[2], r[3]); w.z = cvt_pk_bf16(r[4], r[5]); w.w = cvt_pk_bf16(r[6], r[7]);
                *(u32x4*)rowp = w; }
    }
};

template <class Epi, class Sched>
__device__ __forceinline__ void gemm_phase(const int tidx, LAS unsigned char* lds, const Gemm g, const Sched& S, const Epi& E) {
    const int tid = tidx, wid = __builtin_amdgcn_readfirstlane(tid >> 6), lane = tid & 63, wr = wid >> 2, wc = wid & 3, fr = lane & 15, fq = lane >> 4;
    const int K = g.K, nt = K / BK, lda = g.lda, ldb = g.ldb;
    unsigned voffA[2], voffB[2];
#pragma unroll
    for (int i = 0; i < 2; ++i) { int R, C; stage_rc(tid * 16 + i * 8192, R, C); const int Rb = Epi::PERM ? ((R & ~31) + perm32(R & 31)) : R;
        voffA[i] = (unsigned)(R * lda + C) * 2u; voffB[i] = (unsigned)(Rb * ldb + C) * 2u; }
    const size_t kstep = (size_t)(BK * 2);
    const size_t hstepA = (size_t)HALF * lda * 2, hstepB = (size_t)HALF * ldb * 2;
    const size_t kzstep = (size_t)K * 2;
    const size_t tstepA = 2 * hstepA, tstepB = 2 * hstepB;
    const unsigned ldsw = (unsigned)wid * 1024u;
    const int aoff = lds_byte(wr * 64 + fr, fq * 8), boff = lds_byte(wc * 32 + fr, fq * 8);
#define PG8_SA(b, h) (((b) * 2 + (h)) * HTB)
#define PG8_SB(b, h) ((4 + (b) * 2 + (h)) * HTB)
#define PG8_STAGE(bufoff, gbase, voff) do { _Pragma("unroll") for (int _i = 0; _i < 2; ++_i) \
        __builtin_amdgcn_global_load_lds((const unsigned*)((const char*)(gbase) + (voff)[_i]), (LAS unsigned*)(lds + (bufoff) + ldsw + _i * 8192), 16, 0, 0); } while (0)
#define PG8_LDA(dst, b, h) do { _Pragma("unroll") for (int m = 0; m < 4; ++m) _Pragma("unroll") for (int k = 0; k < 2; ++k) dst[m][k] = *(const LAS bf16x8*)(lds + PG8_SA(b, h) + aoff + m * 2048 + k * 1024); } while (0)
#define PG8_LDB(dst, b, h) do { _Pragma("unroll") for (int n = 0; n < 2; ++n) _Pragma("unroll") for (int k = 0; k < 2; ++k) dst[n][k] = *(const LAS bf16x8*)(lds + PG8_SB(b, h) + boff + n * 2048 + k * 1024); } while (0)
#define PG8_MMA(ai, bj, At, Bt) do { __builtin_amdgcn_s_setprio(1); _Pragma("unroll") for (int m = 0; m < 4; ++m) _Pragma("unroll") for (int n = 0; n < 2; ++n) _Pragma("unroll") for (int k = 0; k < 2; ++k) \
        acc[ai][bj][m][n] = __builtin_amdgcn_mfma_f32_16x16x32_bf16(Bt[n][k], At[m][k], acc[ai][bj][m][n], 0, 0, 0); __builtin_amdgcn_s_setprio(0); } while (0)
#define PG8_WAIT_V(n) asm volatile("s_waitcnt vmcnt(" #n ")" ::: "memory")
#define PG8_WAIT_L(n) asm volatile("s_waitcnt lgkmcnt(" #n ")" ::: "memory")
#define PG8_BAR __builtin_amdgcn_s_barrier()
#define PG8_SCHED __builtin_amdgcn_sched_barrier(0)
    Unit cur, nxt; int ui = 0;
    if (!S.next(0, cur)) return;
    f32x4 acc[2][2][4][2];
#pragma unroll
    for (int a = 0; a < 2; ++a)
#pragma unroll
        for (int b = 0; b < 2; ++b)
#pragma unroll
            for (int m = 0; m < 4; ++m)
#pragma unroll
                for (int n = 0; n < 2; ++n) acc[a][b][m][n] = (f32x4){0.f, 0.f, 0.f, 0.f};
    bf16x8 At[4][2], B0[2][2], B1[2][2];
    const char* cA = (const char*)g.A + (size_t)cur.pm * tstepA + (size_t)cur.kz * kzstep; const char* cB = (const char*)g.Bt + (size_t)cur.pn * tstepB + (size_t)cur.kz * kzstep;
    PG8_STAGE(PG8_SB(0, 0), cB, voffB); PG8_STAGE(PG8_SA(0, 0), cA, voffA); PG8_STAGE(PG8_SB(0, 1), cB + hstepB, voffB); PG8_STAGE(PG8_SA(0, 1), cA + hstepA, voffA);
    if (wr == 1) PG8_BAR;
    PG8_WAIT_V(4); PG8_BAR;
    PG8_STAGE(PG8_SB(1, 0), cB + kstep, voffB); PG8_STAGE(PG8_SA(1, 0), cA + kstep, voffA); PG8_STAGE(PG8_SB(1, 1), cB + hstepB + kstep, voffB);
    PG8_WAIT_V(6); PG8_BAR;
    for (;;) {
        const bool has_next = S.next(ui + 1, nxt);
        const char* nA = has_next ? (const char*)g.A + (size_t)nxt.pm * tstepA + (size_t)nxt.kz * kzstep : cA; const char* nB = has_next ? (const char*)g.Bt + (size_t)nxt.pn * tstepB + (size_t)nxt.kz * kzstep : cB;
        for (int t = 0; t < nt; t += 2) {
            const bool last = (t == nt - 2);
            const char* a1 = cA + (size_t)(t + 1) * kstep;
            const char* a2 = last ? nA : cA + (size_t)(t + 2) * kstep; const char* b2 = last ? nB : cB + (size_t)(t + 2) * kstep;
            const char* a3 = a2 + kstep; const char* b3 = b2 + kstep;
            PG8_LDB(B0, 0, 0); PG8_SCHED; PG8_LDA(At, 0, 0); PG8_STAGE(PG8_SA(1, 1), a1 + hstepA, voffA);
            PG8_WAIT_L(8); PG8_BAR; PG8_WAIT_L(0); PG8_MMA(0, 0, At, B0); PG8_BAR; PG8_SCHED;
            PG8_LDB(B1, 0, 1); PG8_STAGE(PG8_SB(0, 0), b2, voffB);
            PG8_BAR; PG8_WAIT_L(0); PG8_MMA(0, 1, At, B1); PG8_BAR;
            PG8_LDA(At, 0, 1); PG8_STAGE(PG8_SA(0, 0), a2, voffA);
            PG8_BAR; PG8_WAIT_L(0); PG8_MMA(1, 0, At, B0); PG8_BAR; PG8_SCHED;
            PG8_STAGE(PG8_SB(0, 1), b2 + hstepB, voffB);
            PG8_WAIT_V(6); PG8_BAR; PG8_MMA(1, 1, At, B1); PG8_BAR;
            PG8_LDB(B0, 1, 0); PG8_SCHED; PG8_LDA(At, 1, 0); PG8_STAGE(PG8_SA(0, 1), a2 + hstepA, voffA);
            PG8_WAIT_L(8); PG8_BAR; PG8_WAIT_L(0); PG8_MMA(0, 0, At, B0); PG8_BAR; PG8_SCHED;
            PG8_LDB(B1, 1, 1); PG8_STAGE(PG8_SB(1, 0), b3, voffB);
            PG8_BAR; PG8_WAIT_L(0); PG8_MMA(0, 1, At, B1); PG8_BAR;
            PG8_LDA(At, 1, 1); PG8_STAGE(PG8_SA(1, 0), a3, voffA);
            PG8_BAR; PG8_WAIT_L(0); PG8_MMA(1, 0, At, B0); PG8_BAR; PG8_SCHED;
            PG8_STAGE(PG8_SB(1, 1), b3 + hstepB, voffB);
            PG8_WAIT_V(6); PG8_BAR; PG8_MMA(1, 1, At, B1); PG8_BAR;
        }
        E(acc, cur, wr, wc, fr, fq);
        if (!has_next) break;
#pragma unroll
        for (int a = 0; a < 2; ++a)
#pragma unroll
            for (int b = 0; b < 2; ++b)
#pragma unroll
                for (int m = 0; m < 4; ++m)
#pragma unroll
                    for (int n = 0; n < 2; ++n) acc[a][b][m][n] = (f32x4){0.f, 0.f, 0.f, 0.f};
        cur = nxt; cA = nA; cB = nB; ++ui;
    }
    PG8_WAIT_V(0);
    if (wr == 0) PG8_BAR;
    PG8_BAR;
#undef PG8_SA
#undef PG8_SB
#undef PG8_STAGE
#undef PG8_LDA
#undef PG8_LDB
#undef PG8_MMA
#undef PG8_WAIT_V
#undef PG8_WAIT_L
#undef PG8_BAR
#undef PG8_SCHED
}
}

__device__ __forceinline__ void conv_job(const int tidx, LAS float* tile, const float* W, int K, int N, bf16_t* Wt, int Npad, int mode) {
    const int tid = tidx;
    const int tk = K / 128, tn = Npad / 64, nt_all = tk * tn;
    const int nn = tid & 63, kk = tid >> 6, on = tid >> 3, ks = (tid & 7) * 16;
    float v[16];
#define CJ_LOAD(t_) do { const int kt_ = (t_) % tk, nq_ = (t_) / tk, k0_ = kt_ * 128, n0_ = nq_ * 64; \
        const int s0_ = mode ? (((n0_ & 255) >> 7) * DFF + (n0_ >> 8) * 128 + (n0_ & 127)) : n0_; \
        _Pragma("unroll") for (int i = 0; i < 16; ++i) v[i] = (s0_ + nn < N) ? W[(size_t)(k0_ + kk + i * 8) * N + s0_ + nn] : 0.f; } while (0)
    int t = blockIdx.x;
    if (t < nt_all) CJ_LOAD(t);
    for (; t < nt_all; t += gridDim.x) {
        const int kt = t % tk, nq = t / tk, k0 = kt * 128, n0 = nq * 64;
#pragma unroll
        for (int i = 0; i < 16; ++i) tile[(kk + i * 8) * 65 + nn] = v[i];
        __syncthreads();
        if (t + (int)gridDim.x < nt_all) CJ_LOAD(t + (int)gridDim.x);
        float f[16];
#pragma unroll
        for (int i = 0; i < 16; ++i) f[i] = tile[(ks + i) * 65 + on];
        u32x4 w0, w1;
        w0.x = cvt_pk_bf16(f[0], f[1]); w0.y = cvt_pk_bf16(f[2], f[3]); w0.z = cvt_pk_bf16(f[4], f[5]); w0.w = cvt_pk_bf16(f[6], f[7]);
        w1.x = cvt_pk_bf16(f[8], f[9]); w1.y = cvt_pk_bf16(f[10], f[11]); w1.z = cvt_pk_bf16(f[12], f[13]); w1.w = cvt_pk_bf16(f[14], f[15]);
        bf16_t* dst = Wt + (size_t)(n0 + on) * K + k0 + ks;
        *(u32x4*)dst = w0; *(u32x4*)(dst + 8) = w1;
        lds_barrier();
    }
#undef CJ_LOAD
}

__device__ __forceinline__ void row_load(PP p, const float* f, bool first, int row, int lane, f32x4 (&xv)[4], f32x4 (&fv)[4], int nsl) {
    const float* xin = first ? (row < TP ? p->in[0] + (size_t)row * D : p->in[1] + (size_t)(row - TP) * D) : p->out + (size_t)row * D;
#pragma unroll
    for (int i = 0; i < 4; ++i) xv[i] = *(const f32x4*)(xin + lane * 4 + i * 256);
    if (f) {
        if (row < TP) {
#pragma unroll
            for (int i = 0; i < 4; ++i) { const u32x2 w_ = *(const u32x2*)((const bf16_t*)f + (size_t)row * D + lane * 4 + i * 256); fv[i] = (f32x4){bf_lo(w_.x), bf_hi(w_.x), bf_lo(w_.y), bf_hi(w_.y)}; }
        } else {
            const bf16_t* pp = (const bf16_t*)(p->ws + WS_PART) + (size_t)(row - TP) * D + lane * 4;
#pragma unroll
            for (int i = 0; i < 4; ++i) fv[i] = (f32x4){0.f, 0.f, 0.f, 0.f};
            for (int s0 = 0; s0 < nsl; s0 += 6) {
                u32x2 t_[6][4];
#pragma unroll
                for (int u = 0; u < 6; ++u)
#pragma unroll
                    for (int i = 0; i < 4; ++i) t_[u][i] = (s0 + u < nsl) ? *(const u32x2*)(pp + (size_t)(s0 + u) * 1024 * 1024 + i * 256) : (u32x2){0u, 0u};
#pragma unroll
                for (int u = 0; u < 6; ++u)
#pragma unroll
                    for (int i = 0; i < 4; ++i) fv[i] += (f32x4){bf_lo(t_[u][i].x), bf_hi(t_[u][i].x), bf_lo(t_[u][i].y), bf_hi(t_[u][i].y)};
            }
        }
    }
}
__device__ __forceinline__ void row_proc(float* X, bf16_t* H, bool hasf, bool first, bool haspre, float coef, int row, int lane, f32x4 (&xv)[4], const f32x4 (&fv)[4], const f32x4 (&wpo)[4], const f32x4 (&wpr)[4]) {
    if (hasf) {
        float ss = 0.f;
#pragma unroll
        for (int i = 0; i < 4; ++i) ss += fv[i][0] * fv[i][0] + fv[i][1] * fv[i][1] + fv[i][2] * fv[i][2] + fv[i][3] * fv[i][3];
        ss = red64(ss); const float rr = coef * rsqrtf(ss * (1.0f / D) + EPS);
#pragma unroll
        for (int i = 0; i < 4; ++i) xv[i] += fv[i] * wpo[i] * rr;
    }
    if (hasf) {
#pragma unroll
        for (int i = 0; i < 4; ++i) *(f32x4*)(X + (size_t)row * D + lane * 4 + i * 256) = xv[i];
    }
    if (haspre) {
        float ss = 0.f;
#pragma unroll
        for (int i = 0; i < 4; ++i) ss += xv[i][0] * xv[i][0] + xv[i][1] * xv[i][1] + xv[i][2] * xv[i][2] + xv[i][3] * xv[i][3];
        ss = red64(ss); const float rr = rsqrtf(ss * (1.0f / D) + EPS);
#pragma unroll
        for (int i = 0; i < 4; ++i) { const f32x4 hv = xv[i] * wpr[i] * rr;
            u32x2 o; o.x = cvt_pk_bf16(hv[0], hv[1]); o.y = cvt_pk_bf16(hv[2], hv[3]); *(u32x2*)(H + (size_t)row * D + lane * 4 + i * 256) = o; }
    }
}
__device__ __forceinline__ void row_phase(PP p, const int tidx, const float* f, float coef, const float* w_post, const float* w_pre, bool first, int nsl) {
    const int lane = tidx & 63, gw = blockIdx.x * 8 + (tidx >> 6), nw = gridDim.x * 8;
    float* X = p->out; bf16_t* H = (bf16_t*)(p->ws + WS_H);
    f32x4 wpo[4], wpr[4];
#pragma unroll
    for (int i = 0; i < 4; ++i) { wpo[i] = f ? *(const f32x4*)(w_post + lane * 4 + i * 256) : (f32x4){0.f, 0.f, 0.f, 0.f}; wpr[i] = w_pre ? *(const f32x4*)(w_pre + lane * 4 + i * 256) : (f32x4){0.f, 0.f, 0.f, 0.f}; }
    f32x4 xa[4], fa[4], xb[4], fb[4];
    int cur = gw;
    if (cur < T) row_load(p, f, first, cur, lane, xa, fa, nsl);
    while (cur < T) {
        const int nxt = cur + nw;
        if (nxt < T) row_load(p, f, first, nxt, lane, xb, fb, nsl);
        row_proc(X, H, f != nullptr, first, w_pre != nullptr, coef, cur, lane, xa, fa, wpo, wpr);
        if (nxt >= T) break;
        const int nn = nxt + nw;
        if (nn < T) row_load(p, f, first, nn, lane, xa, fa, nsl);
        row_proc(X, H, f != nullptr, first, w_pre != nullptr, coef, nxt, lane, xb, fb, wpo, wpr);
        cur = nn;
    }
}

template <int MODE> __device__ __forceinline__ void prep_phase(PP p, const int tidx, int j) {
    const int lane = tidx & 63, gw = blockIdx.x * 8 + (tidx >> 6), nw = gridDim.x * 8, hh = lane >> 4, eg = lane & 15;
    constexpr int ldp = MODE == 0 ? NGDN : NSSD, choff = MODE == 0 ? 0 : 2048;
    const bf16_t* P = (const bf16_t*)(p->ws + WS_P); float* Q = (float*)(p->ws + WS_Q); float* AB = (float*)(p->ws + WS_AB);
    const float* cw = (MODE == 0 ? p->in[10] : p->in[23]) + (size_t)j * 4 * 3072;
    const float* cb = MODE == 0 ? nullptr : p->in[24] + (size_t)j * 3072;
    const float* cstate = (MODE == 0 ? p->in[3] : p->in[5]) + (size_t)j * 128 * 3 * 3072;
    float* ocp = p->out + (MODE == 0 ? O_GDN_CONV_P : O_SSD_CONV_P) + (size_t)j * 8 * 3 * 3072;
    float* ocs = p->out + (MODE == 0 ? O_GDN_CONV_S : O_SSD_CONV_S) + (size_t)j * 128 * 3 * 3072;
    constexpr int SEG = 17, NSEG = T / SEG;
    static_assert(NSEG * SEG == T, "segments must tile the token rows");
    for (int q = gw; q < NSEG * 6; q += nw) {
        const int seg = q / 6, pass = q - seg * 6;
        const int c = pass * 512 + hh * 128 + eg * 8;
        const int r0 = seg * SEG;
        f32x4 w[4][2], bs[2];
#pragma unroll
        for (int d = 0; d < 4; ++d) { w[d][0] = *(const f32x4*)(cw + d * 3072 + c); w[d][1] = *(const f32x4*)(cw + d * 3072 + c + 4); }
        if (MODE == 1) { bs[0] = *(const f32x4*)(cb + c); bs[1] = *(const f32x4*)(cb + c + 4); } else { bs[0] = (f32x4){0.f, 0.f, 0.f, 0.f}; bs[1] = bs[0]; }
        u32x4 raw[SEG + 3];
#pragma unroll
        for (int i = 0; i < SEG + 3; ++i) { const int r = r0 - 3 + i; raw[i] = (r >= 0) ? *(const u32x4*)(P + (size_t)r * ldp + choff + c) : (u32x4){0u, 0u, 0u, 0u}; }
        float win[3][8];
        unpack8(raw[2], win[0]); unpack8(raw[1], win[1]); unpack8(raw[0], win[2]);
#pragma unroll
        for (int i = 0; i < SEG; ++i) {
            const int row = r0 + i;
            const bool prompt = row < TP;
            const int b = prompt ? (row >> 11) : ((row - TP) >> 3), t = prompt ? (row & 2047) : ((row - TP) & 7), L = prompt ? SEQ : 8;
            float cur[8], acc[8];
            unpack8(raw[3 + i], cur);
#pragma unroll
            for (int e = 0; e < 4; ++e) { acc[e] = cur[e] * w[3][0][e] + bs[0][e]; acc[4 + e] = cur[4 + e] * w[3][1][e] + bs[1][e]; }
#pragma unroll
            for (int d = 1; d <= 3; ++d) {
                float pv[8];
                if (t - d >= 0) {
#pragma unroll
                    for (int e = 0; e < 8; ++e) pv[e] = win[d - 1][e];
                } else if (!prompt) { const float* sp = cstate + ((size_t)b * 3 + (3 + t - d)) * 3072 + c; const f32x4 s0 = *(const f32x4*)sp, s1 = *(const f32x4*)(sp + 4);
#pragma unroll
                    for (int e = 0; e < 4; ++e) { pv[e] = s0[e]; pv[4 + e] = s1[e]; }
                } else {
#pragma unroll
                    for (int e = 0; e < 8; ++e) pv[e] = 0.f;
                }
#pragma unroll
                for (int e = 0; e < 4; ++e) { acc[e] += pv[e] * w[3 - d][0][e]; acc[4 + e] += pv[4 + e] * w[3 - d][1][e]; }
            }
            float ss = 0.f;
#pragma unroll
            for (int e = 0; e < 8; ++e) { acc[e] = siluf(acc[e]); ss += acc[e] * acc[e]; }
            if (MODE == 0 && pass < 4) {
                ss = red16(ss); const float r = rsqrtf(ss + EPS) * (pass < 2 ? 0.08838834764831845f : 1.0f);
#pragma unroll
                for (int e = 0; e < 8; ++e) acc[e] *= r;
            }
            { u32x4 o; o.x = cvt_pk_bf16(acc[0], acc[1]); o.y = cvt_pk_bf16(acc[2], acc[3]); o.z = cvt_pk_bf16(acc[4], acc[5]); o.w = cvt_pk_bf16(acc[6], acc[7]);
                *(u32x4*)((bf16_t*)Q + (size_t)row * 3072 + c) = o; }
            if (t >= L - 3) { float* o = (prompt ? ocp : ocs) + ((size_t)b * 3 + (t - (L - 3))) * 3072 + c;
                *(f32x4*)o = (f32x4){cur[0], cur[1], cur[2], cur[3]}; *(f32x4*)(o + 4) = (f32x4){cur[4], cur[5], cur[6], cur[7]}; }
#pragma unroll
            for (int e = 0; e < 8; ++e) { win[2][e] = win[1][e]; win[1][e] = win[0][e]; win[0][e] = cur[e]; }
        }
    }
    if (MODE == 0) {
        for (int idx = blockIdx.x * 512 + tidx; idx < T * 8; idx += gridDim.x * 512) { const int row = idx >> 3, h = idx & 7;
            const float a_in = __uint_as_float((unsigned)P[(size_t)row * ldp + 4096 + h] << 16), b_in = __uint_as_float((unsigned)P[(size_t)row * ldp + 4104 + h] << 16);
            const float g = -__expf(p->in[11][j * 8 + h]) * softplusf_(a_in + p->in[12][j * 8 + h]);
            AB[(size_t)row * 64 + h] = g; AB[(size_t)row * 64 + 8 + h] = sigmoidf_(b_in); }
    } else {
        for (int idx = blockIdx.x * 512 + tidx; idx < T * 32; idx += gridDim.x * 512) { const int row = idx >> 5, h = idx & 31;
            const float dr = __uint_as_float((unsigned)P[(size_t)row * ldp + 5120 + h] << 16);
            const float dt = softplusf_(dr + p->in[25][j * 32 + h]); const float a = -__expf(p->in[26][j * 32 + h]);
            AB[(size_t)row * 64 + h] = dt * a; AB[(size_t)row * 64 + 32 + h] = dt; }
    }
}

template <int MODE> __device__ __forceinline__ void recur_prompt(PP p, const int tidx, LAS float* Ls, int j) {
    const int tid = tidx, wave = tid >> 6, lane = tid & 63, sub = lane >> 4, eg = lane & 15;
    float* Q = (float*)(p->ws + WS_Q); const float* AB = (const float*)(p->ws + WS_AB); float* F = (float*)(p->ws + WS_F);
    constexpr int BUF = 10304, NCH = SEQ / 32;
    const int ntask = MODE == 0 ? 256 : 512;
    for (int task = blockIdx.x; task < ntask; task += gridDim.x) {
        int b, hd, part, offA, offB, offS, offs0, offs1;
        if (MODE == 0) { b = task >> 5; hd = (task >> 2) & 7; part = task & 3; offA = 1024 + hd * 128; offB = hd * 128; offS = 2048 + hd * 128 + part * 32; offs0 = hd; offs1 = 8 + hd; }
        else { b = task >> 6; hd = (task >> 1) & 31; part = task & 1; const int g = hd >> 3; offA = 2048 + g * 128; offB = 2560 + g * 128; offS = hd * 64 + part * 32; offs0 = hd; offs1 = 32 + hd; }
        const float* Qb = Q + (size_t)b * SEQ * 3072; const float* ABb = AB + (size_t)b * SEQ * 64;
        float* Ob = MODE == 0 ? F + (size_t)b * SEQ * 1024 + hd * 128 + part * 32 : Q + (size_t)b * SEQ * 3072 + offS;
        const int ldo = MODE == 0 ? 1024 : 3072;
        const float dsk = MODE == 1 ? p->in[27][j * 32 + hd] : 0.f;
        float S[8];
#pragma unroll
        for (int i = 0; i < 8; ++i) S[i] = 0.f;
        const int tk = tid >> 4, seg = tid & 15;
        f32x4 kr0, kr1, qr0, qr1; f32x2 vr; float sr = 0.f;
#define RC_LOAD(c) do { const float* r_ = Qb + (size_t)((c) * 32 + tk) * 3072; kr0 = *(const f32x4*)(r_ + offA + seg * 8); kr1 = *(const f32x4*)(r_ + offA + seg * 8 + 4); \
        qr0 = *(const f32x4*)(r_ + offB + seg * 8); qr1 = *(const f32x4*)(r_ + offB + seg * 8 + 4); vr = *(const f32x2*)(r_ + offS + seg * 2); \
        if (tid < 64) sr = ABb[(size_t)((c) * 32 + (tid & 31)) * 64 + (tid < 32 ? offs0 : offs1)]; } while (0)
#define RC_STORE(bf) do { LAS float* B_ = Ls + (bf) * BUF; *(LAS f32x4*)(B_ + tk * 128 + seg * 8) = kr0; *(LAS f32x4*)(B_ + tk * 128 + seg * 8 + 4) = kr1; \
        *(LAS f32x4*)(B_ + 4096 + tk * 128 + seg * 8) = qr0; *(LAS f32x4*)(B_ + 4096 + tk * 128 + seg * 8 + 4) = qr1; *(LAS f32x2*)(B_ + 8192 + tk * 32 + seg * 2) = vr; \
        if (tid < 64) B_[9216 + tid] = sr; } while (0)
        RC_LOAD(0); RC_STORE(0); __syncthreads();
#pragma unroll 1
        for (int c = 0; c < NCH; ++c) {
            if (c + 1 < NCH) RC_LOAD(c + 1);
            LAS float* B_ = Ls + (c & 1) * BUF;
#pragma unroll 4
            for (int tt = 0; tt < 32; ++tt) {
                const f32x4 k0 = *(LAS f32x4*)(B_ + tt * 128 + eg * 8), k1 = *(LAS f32x4*)(B_ + tt * 128 + eg * 8 + 4);
                const f32x4 q0 = *(LAS f32x4*)(B_ + 4096 + tt * 128 + eg * 8), q1 = *(LAS f32x4*)(B_ + 4096 + tt * 128 + eg * 8 + 4);
                const float v = B_[8192 + tt * 32 + wave * 4 + sub], s0 = B_[9216 + tt], s1 = B_[9248 + tt];
                float o;
                if (MODE == 0) {
                    float u = S[0] * k0[0] + S[1] * k0[1] + S[2] * k0[2] + S[3] * k0[3] + S[4] * k1[0] + S[5] * k1[1] + S[6] * k1[2] + S[7] * k1[3];
                    u = red16(u);
                    const float w = s1 * (v - s0 * u);
#pragma unroll
                    for (int i = 0; i < 4; ++i) { S[i] = s0 * S[i] + k0[i] * w; S[4 + i] = s0 * S[4 + i] + k1[i] * w; }
                    o = S[0] * q0[0] + S[1] * q0[1] + S[2] * q0[2] + S[3] * q0[3] + S[4] * q1[0] + S[5] * q1[1] + S[6] * q1[2] + S[7] * q1[3];
                    o = red16(o);
                } else {
                    const float xd = v * s1;
#pragma unroll
                    for (int i = 0; i < 4; ++i) { S[i] = s0 * S[i] + k0[i] * xd; S[4 + i] = s0 * S[4 + i] + k1[i] * xd; }
                    o = S[0] * q0[0] + S[1] * q0[1] + S[2] * q0[2] + S[3] * q0[3] + S[4] * q1[0] + S[5] * q1[1] + S[6] * q1[2] + S[7] * q1[3];
                    o = red16(o) + dsk * v;
                }
                if (eg == 0) B_[9280 + tt * 32 + wave * 4 + sub] = o;
            }
            if (c + 1 < NCH) RC_STORE((c + 1) & 1);
            __syncthreads();
            { const f32x2 ov = *(LAS f32x2*)(B_ + 9280 + tk * 32 + seg * 2); *(f32x2*)(Ob + (size_t)(c * 32 + tk) * ldo + seg * 2) = ov; }
        }
#undef RC_LOAD
#undef RC_STORE
        if (MODE == 0) { float* so = p->out + O_GDN_STATE_P + (((size_t)j * 8 + b) * 8 + hd) * 16384 + part * 32 + wave * 4 + sub;
#pragma unroll
            for (int i = 0; i < 8; ++i) so[(size_t)(eg * 8 + i) * 128] = S[i];
        } else { float* so = p->out + O_SSD_STATE_P + ((((size_t)j * 8 + b) * 32 + hd) * 64 + part * 32 + wave * 4 + sub) * 128 + eg * 8;
            *(f32x4*)so = (f32x4){S[0], S[1], S[2], S[3]}; *(f32x4*)(so + 4) = (f32x4){S[4], S[5], S[6], S[7]}; }
        __syncthreads();
    }
}


__device__ __forceinline__ bf16_t f2bf1(float v) { return (bf16_t)(cvt_pk_bf16(v, 0.f) & 0xffffu); }
__device__ __forceinline__ void ssd_chunked(PP p, const int tidx, LAS unsigned char* lds, int j) {
    const int tid = tidx, wave = __builtin_amdgcn_readfirstlane(tid >> 6), lane = tid & 63, fr = lane & 15, fq = lane >> 4;
    bf16_t* Q = (bf16_t*)(p->ws + WS_Q); const float* AB = (const float*)(p->ws + WS_AB);
    LAS bf16_t* Cs = (LAS bf16_t*)(lds); LAS bf16_t* Bs = (LAS bf16_t*)(lds + 17408); LAS bf16_t* Ss = (LAS bf16_t*)(lds + 34816);
    LAS bf16_t* BT = (LAS bf16_t*)(lds + 52224); LAS bf16_t* XdtT = (LAS bf16_t*)(lds + 70656); LAS bf16_t* XdT = (LAS bf16_t*)(lds + 79872);
    LAS bf16_t* Ms = (LAS bf16_t*)(lds + 89088); LAS float* Gs = (LAS float*)(lds + 98304);
    constexpr int NCH = SEQ / 64;
    for (int task = blockIdx.x; task < 256; task += gridDim.x) {
        const int xcd_ = task & 7, slot_ = task >> 3, grp_ = xcd_ * 4 + (slot_ >> 3);
        const int b = grp_ >> 2, g = grp_ & 3, hd = g * 8 + (slot_ & 7);
        bf16_t* Qb = Q + (size_t)b * SEQ * 3072; const float* ABb = AB + (size_t)b * SEQ * 64;
        const float dsk = p->in[27][j * 32 + hd];
        f32x4 Sacc[4];
#pragma unroll
        for (int t = 0; t < 4; ++t) Sacc[t] = (f32x4){0.f, 0.f, 0.f, 0.f};
        for (int i = tid; i < 17408 / 4; i += 512) ((LAS unsigned*)Ss)[i] = 0u;
        struct SCRegs { u32x4 rb[2], rc[2], rx; float rla, rdt; };
        SCRegs rs[2];
#define SC_LOAD(c, R) do { const bf16_t* row_ = Qb + (size_t)((c) * 64 + lane) * 3072; \
        (R).rb[0] = *(const u32x4*)(row_ + 2048 + g * 128 + wave * 16); (R).rb[1] = *(const u32x4*)(row_ + 2048 + g * 128 + wave * 16 + 8); \
        (R).rc[0] = *(const u32x4*)(row_ + 2560 + g * 128 + wave * 16); (R).rc[1] = *(const u32x4*)(row_ + 2560 + g * 128 + wave * 16 + 8); \
        (R).rx = *(const u32x4*)(row_ + hd * 64 + wave * 8); \
        (R).rla = ABb[(size_t)((c) * 64 + lane) * 64 + hd]; (R).rdt = ABb[(size_t)((c) * 64 + lane) * 64 + 32 + hd]; } while (0)
        SC_LOAD(0, rs[0]); SC_LOAD(1, rs[1]);
#pragma unroll 1
        for (int c0 = 0; c0 < NCH; c0 += 2) {
#pragma unroll
        for (int u_ = 0; u_ < 2; ++u_) {
            const int c = c0 + u_; SCRegs& R = rs[u_];
            const u32x4 rb0 = R.rb[0], rb1 = R.rb[1], rc0 = R.rc[0], rc1 = R.rc[1], rxw = R.rx; const float rla = R.rla, rdt = R.rdt;
            float G = rla;
#pragma unroll
            for (int d = 1; d < 64; d <<= 1) { const float t_ = __shfl_up(G, d); if (lane >= d) G += t_; }
            const float Glast = __shfl(G, 63); const float dtj = rdt; const float ed = __expf(Glast - G) * dtj;
            { *(LAS u32x4*)(Bs + lane * 136 + wave * 16) = rb0; *(LAS u32x4*)(Bs + lane * 136 + wave * 16 + 8) = rb1;
              const unsigned ww[8] = {rb0.x, rb0.y, rb0.z, rb0.w, rb1.x, rb1.y, rb1.z, rb1.w};
#pragma unroll
              for (int e = 0; e < 8; ++e) { BT[(wave * 16 + 2 * e) * 72 + lane] = (bf16_t)(ww[e] & 0xffffu); BT[(wave * 16 + 2 * e + 1) * 72 + lane] = (bf16_t)(ww[e] >> 16); }
              *(LAS u32x4*)(Cs + lane * 136 + wave * 16) = rc0; *(LAS u32x4*)(Cs + lane * 136 + wave * 16 + 8) = rc1; }
            { float xf[8]; unpack8(rxw, xf);
#pragma unroll
              for (int e = 0; e < 8; ++e) { XdtT[(wave * 8 + e) * 72 + lane] = f2bf1(xf[e] * dtj); XdT[(wave * 8 + e) * 72 + lane] = f2bf1(xf[e] * ed); } }
            if (wave == 0) Gs[lane] = G;
            if (c + 2 < NCH) SC_LOAD(c + 2, R);
            lds_barrier();
            const int ti = wave >> 1, th = (wave & 1) * 2;
            f32x4 yacc[2], cb[2];
#pragma unroll
            for (int t = 0; t < 2; ++t) { yacc[t] = (f32x4){0.f, 0.f, 0.f, 0.f}; cb[t] = (f32x4){0.f, 0.f, 0.f, 0.f}; }
#pragma unroll
            for (int ks = 0; ks < 4; ++ks) {
                const bf16x8 a = *(const LAS bf16x8*)(Cs + (ti * 16 + fr) * 136 + ks * 32 + fq * 8);
#pragma unroll
                for (int t = 0; t < 2; ++t) {
                    const bf16x8 sb = *(const LAS bf16x8*)(Ss + ((th + t) * 16 + fr) * 136 + ks * 32 + fq * 8);
                    const bf16x8 bb = *(const LAS bf16x8*)(Bs + ((th + t) * 16 + fr) * 136 + ks * 32 + fq * 8);
                    yacc[t] = __builtin_amdgcn_mfma_f32_16x16x32_bf16(a, sb, yacc[t], 0, 0, 0);
                    if (th + t <= ti) cb[t] = __builtin_amdgcn_mfma_f32_16x16x32_bf16(a, bb, cb[t], 0, 0, 0);
                }
            }
            float gi[4];
#pragma unroll
            for (int jj = 0; jj < 4; ++jj) gi[jj] = Gs[ti * 16 + fq * 4 + jj];
#pragma unroll
            for (int t = 0; t < 2; ++t) {
                const int jc = (th + t) * 16 + fr; const float gj = Gs[jc];
#pragma unroll
                for (int jj = 0; jj < 4; ++jj) { const int i = ti * 16 + fq * 4 + jj;
                    yacc[t][jj] *= __expf(gi[jj]);
                    const float mv = (jc <= i) ? cb[t][jj] * __expf(gi[jj] - gj) : 0.f;
                    Ms[i * 72 + jc] = f2bf1(mv); }
            }
            lds_barrier();
#pragma unroll
            for (int ks = 0; ks < 2; ++ks) {
                if (ks * 32 > ti * 16 + 15) continue;
                const bf16x8 a = *(const LAS bf16x8*)(Ms + (ti * 16 + fr) * 72 + ks * 32 + fq * 8);
#pragma unroll
                for (int t = 0; t < 2; ++t) { const bf16x8 xb = *(const LAS bf16x8*)(XdtT + ((th + t) * 16 + fr) * 72 + ks * 32 + fq * 8);
                    yacc[t] = __builtin_amdgcn_mfma_f32_16x16x32_bf16(a, xb, yacc[t], 0, 0, 0); }
            }
#pragma unroll
            for (int t = 0; t < 2; ++t)
#pragma unroll
                for (int jj = 0; jj < 4; ++jj) { bf16_t* addr = Qb + (size_t)(c * 64 + ti * 16 + fq * 4 + jj) * 3072 + hd * 64 + (th + t) * 16 + fr; const float xv = __uint_as_float((unsigned)*addr << 16); *addr = f2bf1(yacc[t][jj] + dsk * xv); }
            const float eL = __expf(Glast); const int tn0 = (wave & 1) * 4;
#pragma unroll
            for (int t = 0; t < 4; ++t) Sacc[t] *= eL;
#pragma unroll
            for (int ks = 0; ks < 2; ++ks) {
                const bf16x8 a = *(const LAS bf16x8*)(XdT + (ti * 16 + fr) * 72 + ks * 32 + fq * 8);
#pragma unroll
                for (int t = 0; t < 4; ++t) { const bf16x8 bb = *(const LAS bf16x8*)(BT + ((tn0 + t) * 16 + fr) * 72 + ks * 32 + fq * 8);
                    Sacc[t] = __builtin_amdgcn_mfma_f32_16x16x32_bf16(a, bb, Sacc[t], 0, 0, 0); }
            }
#pragma unroll
            for (int t = 0; t < 4; ++t)
#pragma unroll
                for (int jj = 0; jj < 4; ++jj) Ss[(ti * 16 + fq * 4 + jj) * 136 + (tn0 + t) * 16 + fr] = f2bf1(Sacc[t][jj]);
            lds_barrier();
        }
        }
#undef SC_LOAD
        { const int tn0 = (wave & 1) * 4, ti = wave >> 1;
          float* so = p->out + O_SSD_STATE_P + (((size_t)j * 8 + b) * 32 + hd) * 64 * 128;
#pragma unroll
          for (int t = 0; t < 4; ++t)
#pragma unroll
              for (int jj = 0; jj < 4; ++jj) so[(size_t)(ti * 16 + fq * 4 + jj) * 128 + (tn0 + t) * 16 + fr] = Sacc[t][jj]; }
    }
}

__device__ __forceinline__ void gdn_r1(PP p, const int tidx, LAS unsigned char* lds, int j) {
    const int tid = tidx, wave = __builtin_amdgcn_readfirstlane(tid >> 6), lane = tid & 63, fr = lane & 15, fq = lane >> 4;
    bf16_t* Q16 = (bf16_t*)(p->ws + WS_Q); bf16_t* P = (bf16_t*)(p->ws + WS_P); float* AB = (float*)(p->ws + WS_AB);
    LAS bf16_t* Ks = (LAS bf16_t*)(lds); LAS bf16_t* Qs = (LAS bf16_t*)(lds + 17408); LAS float* Mf = (LAS float*)(lds + 34816);
    LAS float* RHS = (LAS float*)(lds + 51200); LAS float* Gs = (LAS float*)(lds + 116736); LAS float* Bts = (LAS float*)(lds + 116992);
    u32x4 q0, q1, k0, k1, v0, v1; float gl = 0.f, bt = 0.f;
#define R1_LOAD(task_) do { const int z_ = (task_) & 31, h_ = ((task_) >> 5) & 7, b_ = (task_) >> 8; const size_t rb_ = (size_t)b_ * SEQ + z_ * 64; \
        const bf16_t* rp_ = Q16 + (rb_ + lane) * 3072 + h_ * 128 + wave * 16; \
        q0 = *(const u32x4*)rp_; q1 = *(const u32x4*)(rp_ + 8); k0 = *(const u32x4*)(rp_ + 1024); k1 = *(const u32x4*)(rp_ + 1032); v0 = *(const u32x4*)(rp_ + 2048); v1 = *(const u32x4*)(rp_ + 2056); \
        gl = AB[(rb_ + lane) * 64 + h_]; bt = AB[(rb_ + lane) * 64 + 8 + h_]; } while (0)
    if (blockIdx.x < 2048) R1_LOAD(blockIdx.x);
    for (int task = blockIdx.x; task < 2048; task += gridDim.x) {
        const int z = task & 31, h = (task >> 5) & 7, b = task >> 8;
        const size_t rowbase = (size_t)b * SEQ + z * 64;
        {
            bf16_t* rp = Q16 + (rowbase + lane) * 3072 + h * 128 + wave * 16;
            float G = gl;
#pragma unroll
            for (int d = 1; d < 64; d <<= 1) { const float t_ = __shfl_up(G, d); if (lane >= d) G += t_; }
            const float Glast = __shfl(G, 63); const float eG = __expf(G), eD = __expf(Glast - G);
            *(LAS u32x4*)(Ks + lane * 136 + wave * 16) = k0; *(LAS u32x4*)(Ks + lane * 136 + wave * 16 + 8) = k1;
            *(LAS u32x4*)(Qs + lane * 136 + wave * 16) = q0; *(LAS u32x4*)(Qs + lane * 136 + wave * 16 + 8) = q1;
            float qf[16], kf[16], vf[16];
            unpack8(q0, qf); unpack8(q1, qf + 8); unpack8(k0, kf); unpack8(k1, kf + 8); unpack8(v0, vf); unpack8(v1, vf + 8);
            const float bg = bt * eG;
#pragma unroll
            for (int e = 0; e < 16; e += 4) {
                *(LAS f32x4*)(RHS + lane * 256 + wave * 16 + e) = (f32x4){vf[e] * bt, vf[e + 1] * bt, vf[e + 2] * bt, vf[e + 3] * bt};
                *(LAS f32x4*)(RHS + lane * 256 + 128 + wave * 16 + e) = (f32x4){kf[e] * bg, kf[e + 1] * bg, kf[e + 2] * bg, kf[e + 3] * bg};
            }
            u32x4 o0, o1;
            o0.x = cvt_pk_bf16(qf[0] * eG, qf[1] * eG); o0.y = cvt_pk_bf16(qf[2] * eG, qf[3] * eG); o0.z = cvt_pk_bf16(qf[4] * eG, qf[5] * eG); o0.w = cvt_pk_bf16(qf[6] * eG, qf[7] * eG);
            o1.x = cvt_pk_bf16(qf[8] * eG, qf[9] * eG); o1.y = cvt_pk_bf16(qf[10] * eG, qf[11] * eG); o1.z = cvt_pk_bf16(qf[12] * eG, qf[13] * eG); o1.w = cvt_pk_bf16(qf[14] * eG, qf[15] * eG);
            *(u32x4*)rp = o0; *(u32x4*)(rp + 8) = o1;
            o0.x = cvt_pk_bf16(kf[0] * eD, kf[1] * eD); o0.y = cvt_pk_bf16(kf[2] * eD, kf[3] * eD); o0.z = cvt_pk_bf16(kf[4] * eD, kf[5] * eD); o0.w = cvt_pk_bf16(kf[6] * eD, kf[7] * eD);
            o1.x = cvt_pk_bf16(kf[8] * eD, kf[9] * eD); o1.y = cvt_pk_bf16(kf[10] * eD, kf[11] * eD); o1.z = cvt_pk_bf16(kf[12] * eD, kf[13] * eD); o1.w = cvt_pk_bf16(kf[14] * eD, kf[15] * eD);
            *(u32x4*)(rp + 1024) = o0; *(u32x4*)(rp + 1032) = o1;
            if (wave == 0) { Gs[lane] = G; Bts[lane] = bt; ((float*)(p->ws + WS_G))[(size_t)(b * 8 + h) * SEQ + z * 64 + lane] = G; }
        }
        __syncthreads();
        {
            const int ti = wave >> 1, th = (wave & 1) * 2;
            f32x4 kk[2], qk[2];
#pragma unroll
            for (int t = 0; t < 2; ++t) { kk[t] = (f32x4){0.f, 0.f, 0.f, 0.f}; qk[t] = (f32x4){0.f, 0.f, 0.f, 0.f}; }
#pragma unroll
            for (int ks = 0; ks < 4; ++ks) {
                const bf16x8 ak = *(const LAS bf16x8*)(Ks + (ti * 16 + fr) * 136 + ks * 32 + fq * 8), aq = *(const LAS bf16x8*)(Qs + (ti * 16 + fr) * 136 + ks * 32 + fq * 8);
#pragma unroll
                for (int t = 0; t < 2; ++t) { const bf16x8 bk = *(const LAS bf16x8*)(Ks + ((th + t) * 16 + fr) * 136 + ks * 32 + fq * 8);
                    if (th + t <= ti) { kk[t] = __builtin_amdgcn_mfma_f32_16x16x32_bf16(ak, bk, kk[t], 0, 0, 0); qk[t] = __builtin_amdgcn_mfma_f32_16x16x32_bf16(aq, bk, qk[t], 0, 0, 0); } }
            }
#pragma unroll
            for (int t = 0; t < 2; ++t) { const int jc = (th + t) * 16 + fr; const float gj = Gs[jc];
#pragma unroll
                for (int jj = 0; jj < 4; ++jj) { const int i = ti * 16 + fq * 4 + jj; const float dec = __expf(fminf(Gs[i] - gj, 0.f));
                    Mf[i * 64 + jc] = (jc < i) ? Bts[i] * kk[t][jj] * dec : 0.f;
                    P[(rowbase + i) * NGDN + h * 64 + jc] = f2bf1((jc <= i) ? qk[t][jj] * dec : 0.f); } }
        }
        __syncthreads();
        if (task + (int)gridDim.x < 2048) R1_LOAD(task + (int)gridDim.x);
        if (tid < 256) {
            const int col = tid;
            float x[64];
#pragma unroll
            for (int i = 0; i < 64; ++i) x[i] = RHS[i * 256 + col];
#pragma unroll
            for (int i = 1; i < 64; ++i) {
                float s0 = 0.f, s1 = 0.f, s2 = 0.f, s3 = 0.f;
#pragma unroll
                for (int j4 = 0; j4 < (i + 3) / 4; ++j4) { const f32x4 m = *(const LAS f32x4*)(Mf + i * 64 + j4 * 4);
                    s0 += m[0] * x[j4 * 4]; s1 += m[1] * x[j4 * 4 + 1]; s2 += m[2] * x[j4 * 4 + 2]; s3 += m[3] * x[j4 * 4 + 3]; }
                x[i] -= (s0 + s1) + (s2 + s3);
            }
            if (col < 128) { bf16_t* up = Q16 + rowbase * 3072 + 2048 + h * 128 + col;
#pragma unroll
                for (int i = 0; i < 64; ++i) up[(size_t)i * 3072] = f2bf1(x[i]); }
            else { bf16_t* wp = P + rowbase * NGDN + 512 + h * 128 + (col - 128);
#pragma unroll
                for (int i = 0; i < 64; ++i) wp[(size_t)i * NGDN] = f2bf1(-x[i]); }
        }
        __syncthreads();
    }
#undef R1_LOAD
}

__device__ __forceinline__ void gdn_r2(PP p, const int tidx, LAS unsigned char* lds, int j) {
    const int tid = tidx, wave = __builtin_amdgcn_readfirstlane(tid >> 6), lane = tid & 63, fr = lane & 15, fq = lane >> 4;
    const bf16_t* Q16 = (const bf16_t*)(p->ws + WS_Q); const bf16_t* P = (const bf16_t*)(p->ws + WS_P); const float* AB = (const float*)(p->ws + WS_AB); float* F = (float*)(p->ws + WS_F);
    LAS bf16_t* Wn = (LAS bf16_t*)(lds); LAS bf16_t* QDs = (LAS bf16_t*)(lds + 17408); LAS bf16_t* KDT = (LAS bf16_t*)(lds + 34816);
    LAS bf16_t* ATs = (LAS bf16_t*)(lds + 53248); LAS bf16_t* ST = (LAS bf16_t*)(lds + 62464); LAS bf16_t* VT = (LAS bf16_t*)(lds + 71168);
    const int ti = wave >> 1, te = wave & 1, lr = tid >> 4, lsg = tid & 15;
    for (int task = blockIdx.x; task < 256; task += gridDim.x) {
        const int xcd_ = task & 7, slot_ = task >> 3, bh_ = xcd_ * 8 + (slot_ >> 2);
        const int dvb = slot_ & 3, h = bh_ & 7, b = bh_ >> 3;
        f32x4 Sacc[2];
        Sacc[0] = (f32x4){0.f, 0.f, 0.f, 0.f}; Sacc[1] = (f32x4){0.f, 0.f, 0.f, 0.f};
        for (int i = tid; i < 8704 / 4; i += 512) ((LAS unsigned*)ST)[i] = 0u;
        struct R2Regs { u32x4 rw0, rw1, rq0, rq1, rk0, rk1, ra; unsigned short ru[4]; float rg; };
        R2Regs rs[2];
#define R2_LOAD(c, R) do { const size_t rb_ = (size_t)b * SEQ + (c) * 64; \
        { const bf16_t* pp_ = P + (rb_ + lr) * NGDN + 512 + h * 128 + lsg * 8; const bf16_t* qq_ = Q16 + (rb_ + lr) * 3072 + h * 128 + lsg * 8; \
          (R).rw0 = *(const u32x4*)pp_; (R).rw1 = *(const u32x4*)(pp_ + (size_t)32 * NGDN); (R).rq0 = *(const u32x4*)qq_; (R).rq1 = *(const u32x4*)(qq_ + (size_t)32 * 3072); \
          (R).rk0 = *(const u32x4*)(qq_ + 1024); (R).rk1 = *(const u32x4*)(qq_ + 1024 + (size_t)32 * 3072); } \
        (R).ra = *(const u32x4*)(P + (rb_ + (tid >> 3)) * NGDN + h * 64 + (tid & 7) * 8); \
        _Pragma("unroll") for (int jj = 0; jj < 4; ++jj) (R).ru[jj] = Q16[(rb_ + ti * 16 + fq * 4 + jj) * 3072 + 2048 + h * 128 + dvb * 32 + te * 16 + fr]; \
        (R).rg = ((const float*)(p->ws + WS_G))[(size_t)(b * 8 + h) * SEQ + (c) * 64 + 63]; } while (0)
        R2_LOAD(0, rs[0]); R2_LOAD(1, rs[1]);
#pragma unroll 1
        for (int c0 = 0; c0 < SEQ / 64; c0 += 2) {
#pragma unroll
        for (int u_ = 0; u_ < 2; ++u_) {
            const int c = c0 + u_; R2Regs& R = rs[u_];
            const u32x4 rw0 = R.rw0, rw1 = R.rw1, rq0 = R.rq0, rq1 = R.rq1, rk0 = R.rk0, rk1 = R.rk1, ra = R.ra; const float rg = R.rg;
            unsigned short ru[4];
#pragma unroll
            for (int jj = 0; jj < 4; ++jj) ru[jj] = R.ru[jj];
            *(LAS u32x4*)(Wn + lr * 136 + lsg * 8) = rw0; *(LAS u32x4*)(Wn + (lr + 32) * 136 + lsg * 8) = rw1;
            *(LAS u32x4*)(QDs + lr * 136 + lsg * 8) = rq0; *(LAS u32x4*)(QDs + (lr + 32) * 136 + lsg * 8) = rq1;
            *(LAS u32x4*)(KDT + lr * 136 + lsg * 8) = rk0; *(LAS u32x4*)(KDT + (lr + 32) * 136 + lsg * 8) = rk1;
            *(LAS u32x4*)(ATs + (tid >> 3) * 72 + (tid & 7) * 8) = ra;
            f32x4 vacc, oacc = (f32x4){0.f, 0.f, 0.f, 0.f};
#pragma unroll
            for (int jj = 0; jj < 4; ++jj) vacc[jj] = __uint_as_float((unsigned)ru[jj] << 16);
            const float gtot = __expf(rg);
            if (c + 2 < SEQ / 64) R2_LOAD(c + 2, R);
            lds_barrier();
#pragma unroll
            for (int ks = 0; ks < 4; ++ks) {
                const bf16x8 sb = *(const LAS bf16x8*)(ST + (te * 16 + fr) * 136 + ks * 32 + fq * 8);
                const bf16x8 aw = *(const LAS bf16x8*)(Wn + (ti * 16 + fr) * 136 + ks * 32 + fq * 8), aq = *(const LAS bf16x8*)(QDs + (ti * 16 + fr) * 136 + ks * 32 + fq * 8);
                vacc = __builtin_amdgcn_mfma_f32_16x16x32_bf16(aw, sb, vacc, 0, 0, 0); oacc = __builtin_amdgcn_mfma_f32_16x16x32_bf16(aq, sb, oacc, 0, 0, 0);
            }
            { u32x2 w; w.x = cvt_pk_bf16(vacc[0], vacc[1]); w.y = cvt_pk_bf16(vacc[2], vacc[3]); *(LAS u32x2*)(VT + (te * 16 + fr) * 72 + ti * 16 + fq * 4) = w; }
            lds_barrier();
#pragma unroll
            for (int ks = 0; ks < 2; ++ks) {
                const bf16x8 aa = *(const LAS bf16x8*)(ATs + (ti * 16 + fr) * 72 + ks * 32 + fq * 8), vb = *(const LAS bf16x8*)(VT + (te * 16 + fr) * 72 + ks * 32 + fq * 8);
                oacc = __builtin_amdgcn_mfma_f32_16x16x32_bf16(aa, vb, oacc, 0, 0, 0);
            }
#pragma unroll
            for (int jj = 0; jj < 4; ++jj) ((bf16_t*)F)[((size_t)b * SEQ + c * 64 + ti * 16 + fq * 4 + jj) * 1024 + h * 128 + dvb * 32 + te * 16 + fr] = f2bf1(oacc[jj]);
            Sacc[0] *= gtot; Sacc[1] *= gtot;
#pragma unroll
            for (int ks = 0; ks < 2; ++ks) {
                bf16x8 ak;
#pragma unroll
                for (int e = 0; e < 8; ++e) ak[e] = (short)KDT[(ks * 32 + fq * 8 + e) * 136 + wave * 16 + fr];
#pragma unroll
                for (int t = 0; t < 2; ++t) { const bf16x8 vb = *(const LAS bf16x8*)(VT + (t * 16 + fr) * 72 + ks * 32 + fq * 8); Sacc[t] = __builtin_amdgcn_mfma_f32_16x16x32_bf16(ak, vb, Sacc[t], 0, 0, 0); }
            }
#pragma unroll
            for (int t = 0; t < 2; ++t) { u32x2 w; w.x = cvt_pk_bf16(Sacc[t][0], Sacc[t][1]); w.y = cvt_pk_bf16(Sacc[t][2], Sacc[t][3]); *(LAS u32x2*)(ST + (t * 16 + fr) * 136 + wave * 16 + fq * 4) = w; }
            lds_barrier();
        }
        }
#undef R2_LOAD
        float* so = p->out + O_GDN_STATE_P + (((size_t)j * 8 + b) * 8 + h) * 16384 + dvb * 32;
#pragma unroll
        for (int t = 0; t < 2; ++t)
#pragma unroll
            for (int jj = 0; jj < 4; ++jj) so[(size_t)(wave * 16 + fq * 4 + jj) * 128 + t * 16 + fr] = Sacc[t][jj];
    }
}

__device__ __forceinline__ void gdn_sample(PP p, const int tidx, LAS float* Ls, int j) {
    const int tid = tidx, wave = tid >> 6, lane = tid & 63, rgq = lane & 3, cc = lane >> 2, col = wave * 16 + cc;
    const bf16_t* Q16 = (const bf16_t*)(p->ws + WS_Q); const float* AB = (const float*)(p->ws + WS_AB); float* F = (float*)(p->ws + WS_F);
    struct GRegs { float S[32]; float vv[8], aa[8], bb[8]; u32x2 kq; };
    GRegs rs[2];
    const int kt = (tid & 255) >> 5, ksg = tid & 31, koff = tid < 256 ? 1024 : 0, kdst = (tid < 256 ? 0 : 1024) + kt * 128 + ksg * 4;
#define GS_LOAD(task, R) do { const int b_ = (task) >> 3, h_ = (task) & 7, r0_ = TP + b_ * 8; \
        const float* sin_ = p->in[2] + (((size_t)j * 128 + b_) * 8 + h_) * 16384 + (size_t)(rgq * 32) * 128 + col; \
        _Pragma("unroll") for (int i = 0; i < 32; ++i) (R).S[i] = sin_[(size_t)i * 128]; \
        _Pragma("unroll") for (int t = 0; t < 8; ++t) { (R).vv[t] = __uint_as_float((unsigned)Q16[(size_t)(r0_ + t) * 3072 + 2048 + h_ * 128 + col] << 16); (R).aa[t] = AB[(size_t)(r0_ + t) * 64 + h_]; (R).bb[t] = AB[(size_t)(r0_ + t) * 64 + 8 + h_]; } \
        (R).kq = *(const u32x2*)(Q16 + (size_t)(r0_ + kt) * 3072 + koff + h_ * 128 + ksg * 4); } while (0)
    const int G = gridDim.x, t0 = blockIdx.x;
    __syncthreads();
    if (t0 < 1024) GS_LOAD(t0, rs[0]);
    if (t0 + G < 1024) GS_LOAD(t0 + G, rs[1]);
#pragma unroll 1
    for (int tb = t0; tb < 1024; tb += 2 * G) {
#pragma unroll
        for (int u_ = 0; u_ < 2; ++u_) {
            const int task = tb + u_ * G;
            if (task < 1024) {
                GRegs& R = rs[u_];
                const int b = task >> 3, h = task & 7; const int r0 = TP + b * 8;
                float S[32], vv[8], aa[8], bb[8];
#pragma unroll
                for (int i = 0; i < 32; ++i) S[i] = R.S[i];
#pragma unroll
                for (int t = 0; t < 8; ++t) { vv[t] = R.vv[t]; aa[t] = __expf(R.aa[t]); bb[t] = R.bb[t]; }
                { const u32x2 w_ = R.kq; *(LAS f32x4*)(Ls + kdst) = (f32x4){bf_lo(w_.x), bf_hi(w_.x), bf_lo(w_.y), bf_hi(w_.y)}; }
                if (task + 2 * G < 1024) GS_LOAD(task + 2 * G, R);
                lds_barrier();
#pragma unroll
                for (int t = 0; t < 8; ++t) {
                    float u = 0.f;
#pragma unroll
                    for (int i = 0; i < 8; ++i) { const f32x4 k4 = *(const LAS f32x4*)(Ls + t * 128 + rgq * 32 + i * 4); u += S[i * 4] * k4[0] + S[i * 4 + 1] * k4[1] + S[i * 4 + 2] * k4[2] + S[i * 4 + 3] * k4[3]; }
                    u = red4(u);
                    const float av = aa[t], w = bb[t] * (vv[t] - av * u);
                    float o = 0.f;
#pragma unroll
                    for (int i = 0; i < 8; ++i) { const f32x4 k4 = *(const LAS f32x4*)(Ls + t * 128 + rgq * 32 + i * 4); const f32x4 q4 = *(const LAS f32x4*)(Ls + 1024 + t * 128 + rgq * 32 + i * 4);
#pragma unroll
                        for (int e = 0; e < 4; ++e) { S[i * 4 + e] = av * S[i * 4 + e] + k4[e] * w; o += S[i * 4 + e] * q4[e]; } }
                    o = red4(o);
                    if (rgq == 0) ((bf16_t*)F)[(size_t)(r0 + t) * 1024 + h * 128 + col] = f2bf1(o);
                }
                float* so = p->out + O_GDN_STATE_S + (((size_t)j * 128 + b) * 8 + h) * 16384 + (size_t)(rgq * 32) * 128 + col;
#pragma unroll
                for (int i = 0; i < 32; ++i) so[(size_t)i * 128] = S[i];
                lds_barrier();
            }
        }
    }
#undef GS_LOAD
}

__device__ __forceinline__ void ssd_sample(PP p, const int tidx, LAS float* Ls, int j) {
    const int tid = tidx, wave = tid >> 6, lane = tid & 63, r8 = lane >> 3, ng = lane & 7, pr = wave * 8 + r8;
    bf16_t* Q = (bf16_t*)(p->ws + WS_Q); const float* AB = (const float*)(p->ws + WS_AB);
    struct SRegs { f32x4 S[4]; float x[8], la[8], dt[8]; u32x4 bc; float dsk; };
    SRegs rs[2];
    const int bt = (tid >> 5) & 7, bwhich = (tid >> 4) & 1, bseg = tid & 15;
#define SS_LOAD(task, R) do { const int b_ = (task) >> 5, hd_ = (task) & 31, g_ = hd_ >> 3, r0_ = TP + b_ * 8; \
        const float* sin_ = p->in[4] + ((((size_t)j * 128 + b_) * 32 + hd_) * 64 + pr) * 128 + ng * 4; \
        _Pragma("unroll") for (int i = 0; i < 4; ++i) (R).S[i] = *(const f32x4*)(sin_ + i * 32); \
        _Pragma("unroll") for (int t = 0; t < 8; ++t) { (R).x[t] = __uint_as_float((unsigned)Q[(size_t)(r0_ + t) * 3072 + hd_ * 64 + pr] << 16); (R).la[t] = AB[(size_t)(r0_ + t) * 64 + hd_]; (R).dt[t] = AB[(size_t)(r0_ + t) * 64 + 32 + hd_]; } \
        (R).bc = *(const u32x4*)(Q + (size_t)(r0_ + bt) * 3072 + 2048 + bwhich * 512 + g_ * 128 + bseg * 8); (R).dsk = p->in[27][j * 32 + hd_]; } while (0)
    const int G = gridDim.x, t0 = blockIdx.x;
    __syncthreads();
    if (t0 < 4096) SS_LOAD(t0, rs[0]);
    if (t0 + G < 4096) SS_LOAD(t0 + G, rs[1]);
#pragma unroll 1
    for (int tb = t0; tb < 4096; tb += 2 * G) {
#pragma unroll
        for (int u_ = 0; u_ < 2; ++u_) {
            const int task = tb + u_ * G;
            if (task < 4096) {
                SRegs& R = rs[u_];
                const int b = task >> 5, hd = task & 31; const int r0 = TP + b * 8;
                f32x4 S[4]; float xs[8], las[8], dts[8];
#pragma unroll
                for (int i = 0; i < 4; ++i) S[i] = R.S[i];
#pragma unroll
                for (int t = 0; t < 8; ++t) { xs[t] = R.x[t]; las[t] = R.la[t]; dts[t] = R.dt[t]; }
                const float dsk = R.dsk;
                if (tid < 256) { float bf_[8]; unpack8(R.bc, bf_); LAS float* d_ = Ls + (bt * 2 + bwhich) * 128 + bseg * 8; *(LAS f32x4*)d_ = (f32x4){bf_[0], bf_[1], bf_[2], bf_[3]}; *(LAS f32x4*)(d_ + 4) = (f32x4){bf_[4], bf_[5], bf_[6], bf_[7]}; }
                if (task + 2 * G < 4096) SS_LOAD(task + 2 * G, R);
                lds_barrier();
#pragma unroll
                for (int t = 0; t < 8; ++t) {
                    const float dec = __expf(las[t]), xd = xs[t] * dts[t]; float y = 0.f;
#pragma unroll
                    for (int i = 0; i < 4; ++i) { const f32x4 Bv = *(const LAS f32x4*)(Ls + (t * 2) * 128 + ng * 4 + i * 32), Cv = *(const LAS f32x4*)(Ls + (t * 2 + 1) * 128 + ng * 4 + i * 32);
                        S[i] = S[i] * dec + Bv * xd; y += S[i][0] * Cv[0] + S[i][1] * Cv[1] + S[i][2] * Cv[2] + S[i][3] * Cv[3]; }
                    y = red8(y) + dsk * xs[t];
                    if (ng == 0) Q[(size_t)(r0 + t) * 3072 + hd * 64 + pr] = f2bf1(y);
                }
                float* so = p->out + O_SSD_STATE_S + ((((size_t)j * 128 + b) * 32 + hd) * 64 + pr) * 128 + ng * 4;
#pragma unroll
                for (int i = 0; i < 4; ++i) *(f32x4*)(so + i * 32) = S[i];
                lds_barrier();
            }
        }
    }
#undef SS_LOAD
}

__device__ __forceinline__ void gdn_out_phase(PP p, const int tidx, int j) {
    const int lane = tidx & 63, gw = blockIdx.x * 8 + (tidx >> 6), nw = gridDim.x * 8, hh = lane >> 4, eg = lane & 15;
    const bf16_t* F = (const bf16_t*)(p->ws + WS_F); const bf16_t* P = (const bf16_t*)(p->ws + WS_P); bf16_t* H = (bf16_t*)(p->ws + WS_H);
    const float* nwp = p->in[13] + j * 128 + eg * 8;
    const f32x4 n0 = *(const f32x4*)nwp, n1 = *(const f32x4*)(nwp + 4);
    for (int row0 = gw; row0 < T; row0 += 2 * nw) {
        u32x4 orr[2][2]; u32x4 gr[2][2];
#pragma unroll
        for (int r = 0; r < 2; ++r) { const int row = row0 + r * nw;
            if (row < T) {
#pragma unroll
                for (int pass = 0; pass < 2; ++pass) { const int c = pass * 512 + hh * 128 + eg * 8;
                    orr[r][pass] = *(const u32x4*)(F + (size_t)row * 1024 + c); gr[r][pass] = *(const u32x4*)(P + (size_t)row * NGDN + 3072 + c); } } }
#pragma unroll
        for (int r = 0; r < 2; ++r) { const int row = row0 + r * nw;
            if (row < T) {
#pragma unroll
                for (int pass = 0; pass < 2; ++pass) { const int c = pass * 512 + hh * 128 + eg * 8;
                    float of_[8]; unpack8(orr[r][pass], of_); const f32x4 a0 = (f32x4){of_[0], of_[1], of_[2], of_[3]}, a1 = (f32x4){of_[4], of_[5], of_[6], of_[7]};
                    float gt[8]; unpack8(gr[r][pass], gt);
                    float ss = a0[0] * a0[0] + a0[1] * a0[1] + a0[2] * a0[2] + a0[3] * a0[3] + a1[0] * a1[0] + a1[1] * a1[1] + a1[2] * a1[2] + a1[3] * a1[3];
                    ss = red16(ss); const float rr = rsqrtf(ss * (1.0f / 128) + EPS);
                    float v[8];
#pragma unroll
                    for (int i = 0; i < 4; ++i) { v[i] = a0[i] * rr * n0[i] * siluf(gt[i]); v[4 + i] = a1[i] * rr * n1[i] * siluf(gt[4 + i]); }
                    u32x4 w; w.x = cvt_pk_bf16(v[0], v[1]); w.y = cvt_pk_bf16(v[2], v[3]); w.z = cvt_pk_bf16(v[4], v[5]); w.w = cvt_pk_bf16(v[6], v[7]);
                    *(u32x4*)(H + (size_t)row * 1024 + c) = w; } } }
    }
}

__device__ __forceinline__ void ssd_out_phase(PP p, const int tidx, int j) {
    const int lane = tidx & 63, gw = blockIdx.x * 8 + (tidx >> 6), nw = gridDim.x * 8;
    const bf16_t* Q = (const bf16_t*)(p->ws + WS_Q); bf16_t* P = (bf16_t*)(p->ws + WS_P);
    const float* nwp = p->in[28] + (size_t)j * 2048;
    for (int row0 = gw; row0 < T; row0 += 2 * nw) {
        u32x4 yr[2][4]; u32x4 zr[2][4];
#pragma unroll
        for (int r = 0; r < 2; ++r) { const int row = row0 + r * nw;
            if (row < T) {
#pragma unroll
                for (int g = 0; g < 4; ++g) { const int c = g * 512 + lane * 8;
                    yr[r][g] = *(const u32x4*)(Q + (size_t)row * 3072 + c); zr[r][g] = *(const u32x4*)(P + (size_t)row * NSSD + c); } } }
#pragma unroll
        for (int r = 0; r < 2; ++r) { const int row = row0 + r * nw;
            if (row < T) {
#pragma unroll
                for (int g = 0; g < 4; ++g) { const int c = g * 512 + lane * 8;
                    float z[8]; unpack8(zr[r][g], z); float yv[8]; unpack8(yr[r][g], yv);
                    float v[8]; float ss = 0.f;
#pragma unroll
                    for (int i = 0; i < 4; ++i) { v[i] = yv[i] * siluf(z[i]); v[4 + i] = yv[4 + i] * siluf(z[4 + i]); }
#pragma unroll
                    for (int i = 0; i < 8; ++i) ss += v[i] * v[i];
                    ss = red64(ss); const float rr = rsqrtf(ss * (1.0f / 512) + EPS);
                    const f32x4 w0 = *(const f32x4*)(nwp + c), w1 = *(const f32x4*)(nwp + c + 4);
#pragma unroll
                    for (int i = 0; i < 4; ++i) { v[i] *= rr * w0[i]; v[4 + i] *= rr * w1[i]; }
                    u32x4 w; w.x = cvt_pk_bf16(v[0], v[1]); w.y = cvt_pk_bf16(v[2], v[3]); w.z = cvt_pk_bf16(v[4], v[5]); w.w = cvt_pk_bf16(v[6], v[7]);
                    *(u32x4*)(P + (size_t)row * NSSD + c) = w; } } }
    }
}

__device__ __forceinline__ void cm_ln_phase(PP p, const int tidx) {
    const int lane = tidx & 63, gw = blockIdx.x * 8 + (tidx >> 6), nw = gridDim.x * 8;
    bf16_t* P = (bf16_t*)(p->ws + WS_P);
    for (int row0 = gw; row0 < T; row0 += 2 * nw) {
        u32x4 raw[2][4];
#pragma unroll
        for (int r = 0; r < 2; ++r) { const int row = row0 + r * nw;
            if (row < T) {
#pragma unroll
                for (int i = 0; i < 4; ++i) raw[r][i] = *(const u32x4*)(P + (size_t)row * NCM + 2048 + i * 512 + lane * 8); } }
#pragma unroll
        for (int r = 0; r < 2; ++r) { const int row = row0 + r * nw;
            if (row < T) {
                float v[32];
#pragma unroll
                for (int i = 0; i < 4; ++i) unpack8(raw[r][i], v + i * 8);
                float sm = 0.f;
#pragma unroll
                for (int i = 0; i < 32; ++i) sm += v[i];
                sm = red64(sm); const float mu = sm * (1.0f / 2048);
                float q = 0.f;
#pragma unroll
                for (int i = 0; i < 32; ++i) { v[i] -= mu; q += v[i] * v[i]; }
                q = red64(q); const float rr = rsqrtf(q * (1.0f / 2048) + EPS);
#pragma unroll
                for (int i = 0; i < 4; ++i) { const int c = i * 512 + lane * 8;
                    const f32x4 w0 = *(const f32x4*)(p->in[17] + c), w1 = *(const f32x4*)(p->in[17] + c + 4), b0 = *(const f32x4*)(p->in[18] + c), b1 = *(const f32x4*)(p->in[18] + c + 4);
                    float o[8];
#pragma unroll
                    for (int e = 0; e < 4; ++e) { o[e] = v[i * 8 + e] * rr * w0[e] + b0[e]; o[4 + e] = v[i * 8 + 4 + e] * rr * w1[e] + b1[e]; }
                    u32x4 w; w.x = cvt_pk_bf16(o[0], o[1]); w.y = cvt_pk_bf16(o[2], o[3]); w.z = cvt_pk_bf16(o[4], o[5]); w.w = cvt_pk_bf16(o[6], o[7]);
                    *(u32x4*)(P + (size_t)row * NCM + 2048 + c) = w;
                    if (row >= TP) { float* oo = p->out + O_CMLP_V_S + (size_t)(row - TP) * 2048 + c; *(f32x4*)oo = (f32x4){o[0], o[1], o[2], o[3]}; *(f32x4*)(oo + 4) = (f32x4){o[4], o[5], o[6], o[7]}; }
                } } }
    }
}

__device__ __forceinline__ void cm_mix_phase(PP p, const int tidx) {
    const int tid = tidx, wave = tid >> 6, lane = tid & 63, fr = lane & 15, fq = lane >> 4;
    const bf16_t* P = (const bf16_t*)(p->ws + WS_P); const bf16_t* WSB = (const bf16_t*)(p->ws + WS_WSB); bf16_t* MO = (bf16_t*)(p->ws + WS_Q);
    const float* bs = p->in[20];
    for (int unit = blockIdx.x; unit < 1024; unit += gridDim.x) {
        const int hg = unit & 7, z = (unit >> 3) & 15, b = unit >> 7;
        const int rbase = b * SEQ + z * 128, d0 = hg * 256 + wave * 32;
        f32x4 acc[2][8];
#pragma unroll
        for (int a = 0; a < 2; ++a)
#pragma unroll
            for (int c = 0; c < 8; ++c) acc[a][c] = (f32x4){0.f, 0.f, 0.f, 0.f};
#pragma unroll
        for (int ks = 0; ks < 4; ++ks) {
            bf16x8 av[2];
#pragma unroll
            for (int dn = 0; dn < 2; ++dn)
#pragma unroll
                for (int i = 0; i < 8; ++i) av[dn][i] = (short)P[(size_t)(rbase + ks * 32 + fq * 8 + i) * NCM + 2048 + d0 + dn * 16 + fr];
#pragma unroll
            for (int tn = 0; tn < 8; ++tn) {
                if (ks * 32 <= tn * 16 + 15) {
                    const bf16x8 bv = *(const bf16x8*)(WSB + ((size_t)hg * 128 + tn * 16 + fr) * 128 + ks * 32 + fq * 8);
                    acc[0][tn] = __builtin_amdgcn_mfma_f32_16x16x32_bf16(av[0], bv, acc[0][tn], 0, 0, 0);
                    acc[1][tn] = __builtin_amdgcn_mfma_f32_16x16x32_bf16(av[1], bv, acc[1][tn], 0, 0, 0);
                }
            }
        }
#pragma unroll
        for (int tn = 0; tn < 8; ++tn) {
            const int t = tn * 16 + fr; const float bias = bs[hg * 128 + t]; const size_t row = (size_t)(rbase + t);
#pragma unroll
            for (int dn = 0; dn < 2; ++dn) {
                const int d = d0 + dn * 16 + fq * 4;
                const u32x2 uu = *(const u32x2*)(P + row * NCM + d);
                const float o0 = bf_lo(uu.x) * (acc[dn][tn][0] + bias), o1 = bf_hi(uu.x) * (acc[dn][tn][1] + bias), o2 = bf_lo(uu.y) * (acc[dn][tn][2] + bias), o3 = bf_hi(uu.y) * (acc[dn][tn][3] + bias);
                u32x2 w; w.x = cvt_pk_bf16(o0, o1); w.y = cvt_pk_bf16(o2, o3);
                *(u32x2*)(MO + row * 2048 + d) = w;
            }
        }
    }
    const float* wsf = p->in[19];
    for (int unit = blockIdx.x * 8 + wave; unit < 1024; unit += gridDim.x * 8) {
        const int hg = unit & 7, b = unit >> 3; const int r0 = TP + b * 8, d = hg * 256 + lane * 4;
        float vn[8][4];
#pragma unroll
        for (int s = 0; s < 8; ++s) { const u32x2 w = *(const u32x2*)(P + (size_t)(r0 + s) * NCM + 2048 + d); vn[s][0] = bf_lo(w.x); vn[s][1] = bf_hi(w.x); vn[s][2] = bf_lo(w.y); vn[s][3] = bf_hi(w.y); }
#pragma unroll
        for (int t = 0; t < 8; ++t) {
            const float bias = bs[hg * 128 + t]; float m[4] = {bias, bias, bias, bias};
#pragma unroll
            for (int s = 0; s <= t; ++s) { const float w = wsf[((size_t)hg * 128 + t) * 128 + s];
#pragma unroll
                for (int e = 0; e < 4; ++e) m[e] += w * vn[s][e]; }
            const u32x2 uu = *(const u32x2*)(P + (size_t)(r0 + t) * NCM + d);
            u32x2 w; w.x = cvt_pk_bf16(bf_lo(uu.x) * m[0], bf_hi(uu.x) * m[1]); w.y = cvt_pk_bf16(bf_lo(uu.y) * m[2], bf_hi(uu.y) * m[3]);
            *(u32x2*)(MO + (size_t)(r0 + t) * 2048 + d) = w;
        }
    }
}

#define XB_TMO      128
#define XB_XCNT(j)  (256  + 64 * (j))
#define XB_XSUB(j)  (1280 + 64 * (j))
#define XB_XGEN(j)  (2304 + 64 * (j))
#define XB_TOP      3328
#define XB_TOPGEN   3392
#define XCD_BAR_WORDS 3456
#define XB_SPIN_CAP (1u << 22)
__device__ __forceinline__ unsigned xb_ld(unsigned* p)              { return __hip_atomic_load(p, __ATOMIC_RELAXED, __HIP_MEMORY_SCOPE_AGENT); }
__device__ __forceinline__ unsigned xb_add(unsigned* p, unsigned v) { return __hip_atomic_fetch_add(p, v, __ATOMIC_RELAXED, __HIP_MEMORY_SCOPE_AGENT); }
__device__ __forceinline__ unsigned xb_xcc_id() { return (unsigned)__builtin_amdgcn_s_getreg((3 << 11) | 20) & 0xFu; }
#define XB_SPIN(cond, bar) do { unsigned _sp = 0; while (cond) { __builtin_amdgcn_s_sleep(1); \
    if ((++_sp & 255u) == 0u) { if (xb_ld(&(bar)[XB_TMO])) break; if (_sp > XB_SPIN_CAP) { atomicAdd(&(bar)[XB_TMO], 1u); break; } } } } while (0)
struct XcdBarrier { unsigned* bar; unsigned x; volatile LAS unsigned* st; };
__device__ __forceinline__ XcdBarrier xcd_barrier_post(unsigned* bar, volatile LAS unsigned* st) {
    XcdBarrier b; b.bar = bar; b.x = xb_xcc_id(); b.st = st;
    if (threadIdx.x == 0) (void)xb_add(&bar[XB_XCNT(b.x)], 1u);
    return b;
}
__device__ __forceinline__ void xcd_barrier_complete(unsigned* bar, unsigned x, unsigned& nloc, unsigned& nx) {
    const unsigned G = gridDim.x * gridDim.y * gridDim.z;
    unsigned sum, cnt, mine, sp = 0u;
    for (;;) {
        sum = 0u; cnt = 0u; mine = 0u;
#pragma unroll
        for (unsigned j = 0; j < 16; ++j) { const unsigned c = xb_ld(&bar[XB_XCNT(j)]); sum += c; cnt += (c > 0u) ? 1u : 0u; mine = (j == x) ? c : mine; }
        if (sum == G) break;
        __builtin_amdgcn_s_sleep(1);
        if ((++sp & 255u) == 0u) { if (xb_ld(&bar[XB_TMO])) break; if (sp > XB_SPIN_CAP) { atomicAdd(&bar[XB_TMO], 1u); break; } }
    }
    nloc = mine > 0u ? mine : 1u; nx = cnt > 0u ? cnt : 1u;
}
__device__ __forceinline__ void xcd_barrier(const XcdBarrier& b) {
    asm volatile("s_waitcnt vmcnt(0)" ::: "memory");
    __syncthreads();
    if (threadIdx.x == 0) {
        unsigned* bar = b.bar;
        __builtin_amdgcn_s_waitcnt(0);
        unsigned nloc = b.st[0], nx = b.st[1];
        if (nloc == 0u) { xcd_barrier_complete(bar, b.x, nloc, nx); b.st[0] = nloc; b.st[1] = nx; }
        const unsigned old = xb_add(&bar[XB_XSUB(b.x)], 1u);
        const unsigned gen = old / nloc;
        if (old + 1u == (gen + 1u) * nloc) {
            __builtin_amdgcn_fence(__ATOMIC_RELEASE, "agent");
            asm volatile("s_waitcnt vmcnt(0)" ::: "memory");
            const unsigned og = xb_add(&bar[XB_TOP], 1u);
            const unsigned tg = og / nx;
            if (og + 1u == (tg + 1u) * nx) xb_add(&bar[XB_TOPGEN], 1u);
            else XB_SPIN(xb_ld(&bar[XB_TOPGEN]) == tg, bar);
            __builtin_amdgcn_fence(__ATOMIC_ACQUIRE, "agent");
            xb_add(&bar[XB_XGEN(b.x)], 1u);
            asm volatile("s_waitcnt vmcnt(0)" ::: "memory");
        } else {
            XB_SPIN(xb_ld(&bar[XB_XGEN(b.x)]) == gen, bar);
            __builtin_amdgcn_fence(__ATOMIC_ACQUIRE, "agent");
            asm volatile("s_waitcnt vmcnt(0)" ::: "memory");
        }
    }
    __syncthreads();
}

template <bool COOP>
__global__ void __launch_bounds__(512, 2) mk_fwd(Params p_unused) {
    extern __shared__ __attribute__((aligned(16))) unsigned char lds_raw[];
    LAS unsigned char* lds = (LAS unsigned char*)lds_raw;
    PP p0 = (PP)__builtin_amdgcn_kernarg_segment_ptr();
    const int lo = p0->lo, hi = p0->hi;
    XcdBarrier xbar; xbar.bar = nullptr; xbar.x = 0; xbar.st = nullptr;
    if (COOP) { volatile LAS unsigned* st = (volatile LAS unsigned*)(lds + 131072); if (threadIdx.x < 4) st[threadIdx.x] = 0u; __syncthreads();
        xbar = xcd_barrier_post((unsigned*)(p0->ws + WS_BAR), st); }
    for (int ph = lo; ph < hi; ++ph) {
        PP p = p0; asm volatile("" : "+s"(p));
        int tidx = threadIdx.x; asm volatile("" : "+v"(tidx));
        unsigned char* ws = p->ws;
        const int code = p->prog[ph], op = code & 15, layer = (code >> 4) & 3, part = code >> 6;
        const int kind = layer % 3, j = layer / 3;
        if (op == OP_PROLOGUE) {
            LAS float* tile = (LAS float*)lds;
            for (int m = 0; m < 8; ++m) conv_job(tidx, tile, p->in[7] + (size_t)m * 1024 * 5632, 1024, 5632, (bf16_t*)(ws + WS_FFN_IN) + (size_t)m * 5632 * 1024, 5632, 1);
            for (int m = 0; m < 8; ++m) conv_job(tidx, tile, p->in[8] + (size_t)m * 2816 * 1024, 2816, 1024, (bf16_t*)(ws + WS_FFN_OUT) + (size_t)m * 1024 * 2816, 1024, 0);
            for (int m = 0; m < 2; ++m) conv_job(tidx, tile, p->in[9] + (size_t)m * 1024 * 4112, 1024, 4112, (bf16_t*)(ws + WS_GDN_IN) + (size_t)m * NGDN * 1024, NGDN, 0);
            for (int m = 0; m < 2; ++m) conv_job(tidx, tile, p->in[14] + (size_t)m * 1024 * 1024, 1024, 1024, (bf16_t*)(ws + WS_GDN_OUT) + (size_t)m * 1024 * 1024, 1024, 0);
            conv_job(tidx, tile, p->in[15], 1024, 4096, (bf16_t*)(ws + WS_CM_IN), NCM, 0);
            conv_job(tidx, tile, p->in[21], 2048, 1024, (bf16_t*)(ws + WS_CM_OUT), 1024, 0);
            conv_job(tidx, tile, p->in[22], 1024, 5152, (bf16_t*)(ws + WS_SSD_IN), NSSD, 0);
            conv_job(tidx, tile, p->in[29], 2048, 1024, (bf16_t*)(ws + WS_SSD_OUT), 1024, 0);
            { bf16_t* wsb = (bf16_t*)(ws + WS_WSB); const float* w = p->in[19];
              for (int i = blockIdx.x * 512 + tidx; i < 8 * 128 * 128; i += gridDim.x * 512) { const int s = i & 127, t = (i >> 7) & 127; wsb[i] = (bf16_t)(cvt_pk_bf16(s <= t ? w[i] : 0.f, 0.f) & 0xffffu); } }
#if MK_DBG != 1
            row_phase(p, tidx, nullptr, 0.f, nullptr, p->in[6], true, 0);
#endif
        } else if (op == OP_GEMM_SWIGLU) {
            pg8::Gemm g{(const bf16_t*)(ws + WS_H), (const bf16_t*)(ws + WS_FFN_IN) + (size_t)(layer * 2 + (part >> 1)) * 5632 * 1024, T, 5632, 1024, 1024, 1024};
            pg8::StaticOrder S; S.init(T, 5632, gridDim.x, blockIdx.x);
            pg8::EpiSwiGLU E{(bf16_t*)(ws + WS_Q), DFF};
            pg8::gemm_phase(tidx, lds, g, S, E);
        } else if (op == OP_GEMM_F32) {
            const bf16_t* A; const bf16_t* Bt; int K, lda;
            if (part != 1) { A = (const bf16_t*)(ws + WS_Q); Bt = (const bf16_t*)(ws + WS_FFN_OUT) + (size_t)(layer * 2 + (part >> 1)) * 1024 * 2816; K = DFF; lda = DFF; }
            else if (kind == 0) { A = (const bf16_t*)(ws + WS_H); Bt = (const bf16_t*)(ws + WS_GDN_OUT) + (size_t)j * 1024 * 1024; K = 1024; lda = 1024; }
            else if (kind == 1) { A = (const bf16_t*)(ws + WS_Q); Bt = (const bf16_t*)(ws + WS_CM_OUT); K = 2048; lda = 2048; }
            else { A = (const bf16_t*)(ws + WS_P); Bt = (const bf16_t*)(ws + WS_SSD_OUT); K = 2048; lda = NSSD; }
            {
                pg8::Gemm g{A, Bt, TP, 1024, K, lda, K};
                pg8::StaticOrder S; S.init(TP, 1024, gridDim.x, blockIdx.x);
                pg8::EpiBf16<0> E{(bf16_t*)(ws + WS_F), 1024, nullptr};
                pg8::gemm_phase(tidx, lds, g, S, E);
            }
            {
                pg8::Gemm g{A + (size_t)TP * lda, Bt, TS, 1024, 256, lda, K};
                pg8::SplitOrder S; S.init(K / 256, gridDim.x, blockIdx.x);
                pg8::EpiBf16Part E{(bf16_t*)(ws + WS_PART)};
                pg8::gemm_phase(tidx, lds, g, S, E);
            }
        } else if (op == OP_ROW) {
            const float* nw = p->in[6] + (size_t)layer * 6 * D;
            const float coef = part == 1 ? 1.0f : 0.5f;
            const float* wpost = nw + (part * 2 + 1) * D;
            const float* wpre = part < 2 ? nw + (part * 2 + 2) * D : (layer < 3 ? nw + 6 * D : nullptr);
            row_phase(p, tidx, (const float*)(ws + WS_F), coef, wpost, wpre, layer == 0 && part == 0, part != 1 ? 11 : (kind == 0 ? 4 : 8));
        } else if (op == OP_GEMM_IN) {
            const int N = kind == 0 ? NGDN : NSSD;
            pg8::Gemm g{(const bf16_t*)(ws + WS_H), kind == 0 ? (const bf16_t*)(ws + WS_GDN_IN) + (size_t)j * NGDN * 1024 : (const bf16_t*)(ws + WS_SSD_IN), T, N, 1024, 1024, 1024};
            pg8::StaticOrder S; S.init(T, N, gridDim.x, blockIdx.x);
            pg8::EpiBf16<0> E{(bf16_t*)(ws + WS_P), N, nullptr};
            pg8::gemm_phase(tidx, lds, g, S, E);
        } else if (op == OP_GEMM_IN_GELU) {
            pg8::Gemm g{(const bf16_t*)(ws + WS_H), (const bf16_t*)(ws + WS_CM_IN), T, NCM, 1024, 1024, 1024};
            pg8::StaticOrder S; S.init(T, NCM, gridDim.x, blockIdx.x);
            pg8::EpiBf16<1> E{(bf16_t*)(ws + WS_P), NCM, p->in[16]};
            pg8::gemm_phase(tidx, lds, g, S, E);
        } else if (op == OP_GDN_PREP) { prep_phase<0>(p, tidx, j);
        } else if (op == OP_GDN_R1) { gdn_r1(p, tidx, lds, j); gdn_sample(p, tidx, (LAS float*)lds, j);
        } else if (op == OP_GDN_REC) { gdn_r2(p, tidx, lds, j);
        } else if (op == OP_GDN_OUT) { gdn_out_phase(p, tidx, j);
        } else if (op == OP_CM_LN) { cm_ln_phase(p, tidx);
        } else if (op == OP_CM_MIX) { cm_mix_phase(p, tidx);
        } else if (op == OP_SSD_PREP) { prep_phase<1>(p, tidx, j);
        } else if (op == OP_SSD_REC) { ssd_chunked(p, tidx, lds, j); ssd_sample(p, tidx, (LAS float*)lds, j);
        } else if (op == OP_SSD_OUT) { ssd_out_phase(p, tidx, j); }
        if (COOP) { if (ph + 1 < hi) {
#if MK_CGSYNC
            cg::this_grid().sync();
#else
            xcd_barrier(xbar);
#endif
        } }
    }
}

static int build_prog(unsigned char* prog) {
    int n = 0;
    prog[n++] = OP_PROLOGUE;
    for (int layer = 0; layer < 4; ++layer) {
        const int kind = layer % 3;
        auto emit = [&](int op, int part) { prog[n++] = (unsigned char)(op | (layer << 4) | (part << 6)); };
        emit(OP_GEMM_SWIGLU, 0); emit(OP_GEMM_F32, 0); emit(OP_ROW, 0);
        if (kind == 0) { emit(OP_GEMM_IN, 1); emit(OP_GDN_PREP, 1); emit(OP_GDN_R1, 1); emit(OP_GDN_REC, 1); emit(OP_GDN_OUT, 1); }
        else if (kind == 1) { emit(OP_GEMM_IN_GELU, 1); emit(OP_CM_LN, 1); emit(OP_CM_MIX, 1); }
        else { emit(OP_GEMM_IN, 1); emit(OP_SSD_PREP, 1); emit(OP_SSD_REC, 1); emit(OP_SSD_OUT, 1); }
        emit(OP_GEMM_F32, 1); emit(OP_ROW, 1);
        emit(OP_GEMM_SWIGLU, 2); emit(OP_GEMM_F32, 2); emit(OP_ROW, 2);
    }
    return n;
}

extern "C" void kernel_launch(void* const* d_in, const int* in_sizes, int n_in, void* d_out, int out_size, void* d_ws, size_t ws_size, hipStream_t stream) {
    static int grid = 0;
    if (grid == 0) {
        if (n_in != 30 || (size_t)out_size != O_END || ws_size < WS_END) { fprintf(stderr, "kernel_launch: unexpected shapes n_in %d out %d ws %zu (need %zu)\n", n_in, out_size, ws_size, (size_t)WS_END); grid = -1; return; }
        int dev = 0, cus = 0, per_cu = 0;
        hipGetDevice(&dev); hipDeviceGetAttribute(&cus, hipDeviceAttributeMultiprocessorCount, dev);
        hipFuncSetAttribute((const void*)mk_fwd<true>, hipFuncAttributeMaxDynamicSharedMemorySize, LDS_BYTES);
        hipFuncSetAttribute((const void*)mk_fwd<false>, hipFuncAttributeMaxDynamicSharedMemorySize, LDS_BYTES);
        hipOccupancyMaxActiveBlocksPerMultiprocessor(&per_cu, (const void*)mk_fwd<true>, 512, LDS_BYTES);
        per_cu = 1;
        grid = cus * per_cu;
        (void)hipGetLastError();
    }
    if (grid < 0) return;
    Params p{};
    for (int i = 0; i < 30; ++i) p.in[i] = (const float*)d_in[i];
    p.out = (float*)d_out; p.ws = (unsigned char*)d_ws;
    int nph = build_prog(p.prog);
#ifdef MK_NPH
    if (nph > MK_NPH) nph = MK_NPH;
#endif
#if MK_COOP
    p.lo = 0; p.hi = nph;
    hipMemsetAsync((unsigned char*)d_ws + WS_BAR, 0, 16384, stream);
    void* args[] = {&p};
    hipError_t e = hipLaunchCooperativeKernel((const void*)mk_fwd<true>, dim3(grid), dim3(512), args, LDS_BYTES, stream);
    if (e != hipSuccess) fprintf(stderr, "cooperative launch failed: %s (grid %d)\n", hipGetErrorString(e), grid);
#else
    for (int ph = 0; ph < nph; ++ph) { p.lo = ph; p.hi = ph + 1 - MK_EMPTY; hipLaunchKernelGGL(mk_fwd<false>, dim3(grid), dim3(512), LDS_BYTES, stream, p); }
#endif
}
```
